# Optimizing an MI355X kernel written in HIP

```python
import math
import jax, jax.numpy as jnp
from jax import lax
import numpy as np

D_MODEL = 1024
BATCH = 8
SEQ = 2048
DEPTH = 1
DEC_BATCH = 128
DEC_SEQ = 8
PAST_LEN = 16384
PAGE_SIZE = 128

D_MIX = 2 * D_MODEL
D_M = D_MIX // 2
D_H = D_MIX - D_M
M_HEADS = 4
M_DV = D_M // M_HEADS
M_DK = M_DV // 2
CONV_W = 4
H_HEADS = 8
H_DK = D_H // H_HEADS
H_DV = D_H // H_HEADS
CHUNK = 64
EPS = 1e-6
SPLITS = (D_M, D_M, D_M, D_H, D_H, D_H, D_H)
N_IN = sum(SPLITS)
GATE_IN = 2 * M_HEADS * M_DK + D_M

kernel_name = "hybrid_mlstm_hgrn2_step"


def rmsnorm(x, g):
    xf = x.astype(jnp.float32)
    y = xf * lax.rsqrt(jnp.mean(xf * xf, -1, keepdims=True) + EPS)
    return y * g.astype(jnp.float32)


def layernorm(x, g):
    xf = x.astype(jnp.float32)
    mu = jnp.mean(xf, -1, keepdims=True)
    var = jnp.mean(jnp.square(xf - mu), -1, keepdims=True)
    return (xf - mu) * lax.rsqrt(var + EPS) * g.astype(jnp.float32)


def causal_conv(x, buf, w, b):
    T = x.shape[1]
    xp = jnp.concatenate([buf.astype(x.dtype), x], axis=1)
    y = sum(xp[:, j:j + T] * w[j] for j in range(CONV_W)) + b
    return y, xp[:, -(CONV_W - 1):]


def to_chunks(a, nC, L):
    return jnp.moveaxis(a.reshape(a.shape[:2] + (nC, L) + a.shape[3:]), 2, 0)


def from_chunks(a):
    a = jnp.moveaxis(a, 0, 2)
    return a.reshape(a.shape[:2] + (a.shape[2] * a.shape[3],) + a.shape[4:])


def mlstm_scan(q, k, v, ig, lf, C0, n0, m0):
    T = q.shape[2]
    L = math.gcd(T, CHUNK)
    nC = T // L
    causal = jnp.tril(jnp.ones((L, L), bool))

    def step(carry, inp):
        C, n, m = carry
        qc, kc, vc, ic, fc = inp
        b = jnp.cumsum(fc, -1)
        logD = jnp.where(causal, b[..., :, None] - b[..., None, :] + ic[..., None, :], -jnp.inf)
        m_inter = b + m[..., None]
        m_t = jnp.maximum(jnp.max(logD, -1), m_inter)
        D = jnp.exp(logD - m_t[..., None])
        g = jnp.exp(m_inter - m_t)
        s = jnp.einsum('bhtk,bhsk->bhts', qc, kc) * D
        num = jnp.einsum('bhts,bhsv->bhtv', s, vc) + g[..., None] * jnp.einsum('bhtk,bhkv->bhtv', qc, C)
        den = jnp.sum(s, -1) + g * jnp.einsum('bhtk,bhk->bht', qc, n)
        h = num / jnp.maximum(jnp.abs(den), jnp.exp(-m_t))[..., None]
        w = D[..., -1, :]
        decay = g[..., -1]
        C_new = decay[..., None, None] * C + jnp.einsum('bhs,bhsk,bhsv->bhkv', w, kc, vc)
        n_new = decay[..., None] * n + jnp.einsum('bhs,bhsk->bhk', w, kc)
        return (C_new, n_new, m_t[..., -1]), h

    xs = (to_chunks(q, nC, L), to_chunks(k, nC, L), to_chunks(v, nC, L),
          to_chunks(ig, nC, L), to_chunks(lf, nC, L))
    (C, n, m), h = lax.scan(step, (C0, n0, m0), xs)
    return from_chunks(h), C, n, m


def hgrn2_scan(q, k, v, lf, S0):
    T = q.shape[2]
    L = math.gcd(T, CHUNK)
    nC = T // L
    causal = jnp.tril(jnp.ones((L, L), bool))[:, :, None]

    def step(S, inp):
        qc, kc, vc, fc = inp
        b = jnp.cumsum(fc, 2)
        diff = b[:, :, :, None, :] - b[:, :, None, :, :]
        D = jnp.exp(jnp.where(causal, diff, -jnp.inf))
        A = jnp.einsum('bhtk,bhsk,bhtsk->bhts', qc, kc, D)
        o = jnp.einsum('bhts,bhsv->bhtv', A, vc) + jnp.einsum('bhtk,bhkv->bhtv', qc * jnp.exp(b), S)
        kd = kc * jnp.exp(b[:, :, -1:] - b)
        S_new = jnp.exp(b[:, :, -1])[..., None] * S + jnp.einsum('bhsk,bhsv->bhkv', kd, vc)
        return S_new, o

    xs = (to_chunks(q, nC, L), to_chunks(k, nC, L), to_chunks(v, nC, L), to_chunks(lf, nC, L))
    S, o = lax.scan(step, S0, xs)
    return from_chunks(o), S


def mixer_layer(x, conv_buf, C0, n0, m0, S0, lb, g_norm, w_in, conv_w, conv_b, w_q, w_k, w_v,
                w_gate, b_gate, m_ln, m_skip, h_norm, w_out):
    B, T, _ = x.shape
    dt = x.dtype
    f32 = jnp.float32
    xn = rmsnorm(x, g_norm).astype(dt)
    proj = xn @ w_in
    offs = np.cumsum((0,) + SPLITS)
    xm, zm, om, fh, qh, ih, zh = [proj[..., offs[i]:offs[i + 1]] for i in range(len(SPLITS))]

    xc, conv_new = causal_conv(xm, conv_buf, conv_w, conv_b)
    xc = jax.nn.silu(xc)
    xc_h = xc.reshape(B, T, M_HEADS, M_DV)
    xm_h = xm.reshape(B, T, M_HEADS, M_DV)
    q = jnp.einsum('bthd,hdk->bthk', xc_h, w_q)
    k = jnp.einsum('bthd,hdk->bthk', xc_h, w_k)
    v = jnp.einsum('bthd,hdv->bthv', xm_h, w_v)
    gate_in = jnp.concatenate([q.reshape(B, T, -1), k.reshape(B, T, -1), v.reshape(B, T, -1)], -1)
    gates = (gate_in @ w_gate + b_gate).astype(f32)
    ig = jnp.transpose(gates[..., :M_HEADS], (0, 2, 1))
    lf = jnp.transpose(jax.nn.log_sigmoid(gates[..., M_HEADS:]), (0, 2, 1))
    qf = jnp.transpose(q, (0, 2, 1, 3)).astype(f32) * (M_DK ** -0.5)
    kf = jnp.transpose(k, (0, 2, 1, 3)).astype(f32)
    vf = jnp.transpose(v, (0, 2, 1, 3)).astype(f32)
    hm, C1, n1, m1 = mlstm_scan(qf, kf, vf, ig, lf, C0.astype(f32), n0.astype(f32), m0.astype(f32))
    hm = layernorm(jnp.transpose(hm, (0, 2, 1, 3)), m_ln).reshape(B, T, D_M)
    hm = hm * jax.nn.sigmoid(om.astype(f32))
    hm = (hm + m_skip * xc.astype(f32)) * jax.nn.silu(zm.astype(f32))

    fl = fh.astype(f32)
    lbf = lb.astype(f32)
    logf = jnp.log(lbf + (1.0 - lbf) * jax.nn.sigmoid(fl))
    kh = (1.0 - lbf) * jax.nn.sigmoid(-fl)
    qs = jax.nn.silu(qh.astype(f32))
    heads = lambda a: jnp.transpose(a.reshape(B, T, H_HEADS, -1), (0, 2, 1, 3))
    oh, S1 = hgrn2_scan(heads(qs), heads(kh), heads(ih.astype(f32)), heads(logf), S0.astype(f32))
    oh = rmsnorm(jnp.transpose(oh, (0, 2, 1, 3)), h_norm).reshape(B, T, D_H)
    oh = oh * jax.nn.silu(zh.astype(f32))

    mix = jnp.concatenate([hm, oh], -1).astype(dt)
    y = x + mix @ w_out
    return y, conv_new, C1, n1, m1, S1


def setup_inputs(seed: int = 0) -> dict:
    key = jax.random.key(seed)
    ks = jax.random.split(key, 24)
    nrm = jax.random.normal
    f32 = jnp.float32
    b_gate = jnp.concatenate([0.1 * nrm(ks[0], (DEPTH, M_HEADS), f32),
                              3.0 + 0.1 * nrm(ks[1], (DEPTH, M_HEADS), f32)], -1)
    return {
        "x_prompt": nrm(ks[2], (BATCH, SEQ, D_MODEL), f32),
        "x_sample": nrm(ks[3], (DEC_BATCH, DEC_SEQ, D_MODEL), f32),
        "state_mlstm_conv": nrm(ks[4], (DEPTH, DEC_BATCH, CONV_W - 1, D_M), f32),
        "state_mlstm_C": nrm(ks[5], (DEPTH, DEC_BATCH, M_HEADS, M_DK, M_DV), f32),
        "state_mlstm_n": nrm(ks[6], (DEPTH, DEC_BATCH, M_HEADS, M_DK), f32),
        "state_mlstm_m": nrm(ks[7], (DEPTH, DEC_BATCH, M_HEADS), f32),
        "state_hgrn_S": nrm(ks[8], (DEPTH, DEC_BATCH, H_HEADS, H_DK, H_DV), f32),
        "g_norm": 1.0 + 0.02 * nrm(ks[9], (DEPTH, D_MODEL), f32),
        "w_in": nrm(ks[10], (DEPTH, D_MODEL, N_IN), f32) * D_MODEL ** -0.5,
        "conv_w": nrm(ks[11], (DEPTH, CONV_W, D_M), f32) * CONV_W ** -0.5,
        "conv_b": 0.02 * nrm(ks[12], (DEPTH, D_M), f32),
        "w_q": nrm(ks[13], (DEPTH, M_HEADS, M_DV, M_DK), f32) * M_DV ** -0.5,
        "w_k": nrm(ks[14], (DEPTH, M_HEADS, M_DV, M_DK), f32) * M_DV ** -0.5,
        "w_v": nrm(ks[15], (DEPTH, M_HEADS, M_DV, M_DV), f32) * M_DV ** -0.5,
        "w_gate": nrm(ks[16], (DEPTH, GATE_IN, 2 * M_HEADS), f32) * GATE_IN ** -0.5,
        "b_gate": b_gate,
        "m_ln": 1.0 + 0.02 * nrm(ks[17], (DEPTH, M_HEADS, M_DV), f32),
        "m_skip": 1.0 + 0.02 * nrm(ks[18], (DEPTH, D_M), f32),
        "lb_param": 0.5 * nrm(ks[19], (DEPTH + 1, D_H), f32),
        "h_norm": 1.0 + 0.02 * nrm(ks[20], (DEPTH, H_HEADS, H_DV), f32),
        "w_out": nrm(ks[21], (DEPTH, D_MIX, D_MODEL), f32) * D_MIX ** -0.5,
        "g_final": 1.0 + 0.02 * nrm(ks[22], (D_MODEL,), f32),
    }


def reference(x_prompt, x_sample, state_mlstm_conv, state_mlstm_C, state_mlstm_n, state_mlstm_m,
              state_hgrn_S, g_norm, w_in, conv_w, conv_b, w_q, w_k, w_v, w_gate, b_gate, m_ln,
              m_skip, lb_param, h_norm, w_out, g_final):
    f32 = jnp.float32
    lb_all = jnp.cumsum(jax.nn.softmax(lb_param.astype(f32), axis=0), axis=0)
    Bp = x_prompt.shape[0]
    zC = jnp.zeros((Bp, M_HEADS, M_DK, M_DV), f32)
    zn = jnp.zeros((Bp, M_HEADS, M_DK), f32)
    zm = jnp.zeros((Bp, M_HEADS), f32)
    zS = jnp.zeros((Bp, H_HEADS, H_DK, H_DV), f32)
    zconv = jnp.zeros((Bp, CONV_W - 1, D_M), x_prompt.dtype)
    hp, hs = x_prompt, x_sample
    p_new = [[] for _ in range(5)]
    s_new = [[] for _ in range(5)]
    for l in range(DEPTH):
        w = (lb_all[l], g_norm[l], w_in[l], conv_w[l], conv_b[l], w_q[l], w_k[l], w_v[l],
             w_gate[l], b_gate[l], m_ln[l], m_skip[l], h_norm[l], w_out[l])
        hp, *pst = mixer_layer(hp, zconv, zC, zn, zm, zS, *w)
        hs, *sst = mixer_layer(hs, state_mlstm_conv[l], state_mlstm_C[l], state_mlstm_n[l],
                               state_mlstm_m[l], state_hgrn_S[l], *w)
        for i in range(5):
            p_new[i].append(pst[i])
            s_new[i].append(sst[i])
    y_prompt = rmsnorm(hp, g_final).astype(x_prompt.dtype)
    y_sample = rmsnorm(hs, g_final).astype(x_sample.dtype)
    p_conv, p_C, p_n, p_m, p_S = [jnp.stack(a, 0) for a in p_new]
    s_conv, s_C, s_n, s_m, s_S = [jnp.stack(a, 0) for a in s_new]
    return (y_prompt, y_sample, p_conv, p_C, p_n, p_m, p_S, s_conv, s_C, s_n, s_m, s_S)
```

```cpp
#include <hip/hip_runtime.h>
#include <hip/hip_cooperative_groups.h>
#include <cstdio>
namespace cg = cooperative_groups;

typedef unsigned short bf16_t;
typedef short bf16x8 __attribute__((ext_vector_type(8)));
typedef float f32x4 __attribute__((ext_vector_type(4)));
typedef float f32x16 __attribute__((ext_vector_type(16)));
typedef unsigned u32x4 __attribute__((ext_vector_type(4)));
typedef unsigned u32x2 __attribute__((ext_vector_type(2)));
#define LAS __attribute__((address_space(3)))

constexpr int NROWS_P = 16384, NROWS = 17408, DM = 1024;
constexpr size_t UB = (size_t)NROWS * 1024 * 2;
constexpr size_t WS_U0 = 0;
constexpr size_t WS_WOUT = 7 * UB;
constexpr size_t WS_WQK = WS_WOUT + 4194304;
constexpr size_t WS_WV = WS_WQK + 524288;
constexpr size_t WS_GATES = WS_WV + 524288;
constexpr size_t WS_DEN = WS_GATES + (size_t)NROWS * 32;
constexpr size_t WS_MT = WS_DEN + (size_t)NROWS * 16;
constexpr size_t WS_END = WS_MT + (size_t)NROWS * 16;
constexpr size_t YS_XN = 0, YS_WIN = UB, YS_XC = 0, YS_Q = UB, YS_K = UB + UB / 2;
constexpr size_t O_Y = 0, O_PCONV = 17825792, O_PC = 17850368, O_PN = 18898944, O_PM = 18903040, O_PS = 18903072,
                 O_SCONV = 19951648, O_SC = 20344864, O_SN = 37122080, O_SM = 37187616, O_SS = 37188128;

constexpr int LDS_BYTES = 158224;

struct Params {
    const float* x_prompt; const float* x_sample; const float* st_conv; const float* st_C; const float* st_n; const float* st_m; const float* st_S;
    const float* g_norm; const float* w_in; const float* conv_w; const float* conv_b; const float* w_q; const float* w_k; const float* w_v;
    const float* w_gate; const float* b_gate; const float* m_ln; const float* m_skip; const float* lb_param; const float* h_norm; const float* w_out; const float* g_final;
    float* out; unsigned char* ws;
};

typedef __bf16 bf16v2 __attribute__((ext_vector_type(2)));
typedef float f32x2 __attribute__((ext_vector_type(2)));
__device__ __forceinline__ unsigned cvt_pk_bf16(float lo, float hi) { const f32x2 v = {lo, hi}; const bf16v2 r = __builtin_convertvector(v, bf16v2); return __builtin_bit_cast(unsigned, r); }
__device__ __forceinline__ bf16_t f2bf(float f) { return (bf16_t)(cvt_pk_bf16(f, 0.f) & 0xffffu); }
__device__ __forceinline__ float bf2f(bf16_t v) { return __uint_as_float(((unsigned)v) << 16); }
__device__ __forceinline__ float bflo(unsigned w) { return __uint_as_float(w << 16); }
__device__ __forceinline__ float bfhi(unsigned w) { return __uint_as_float(w & 0xffff0000u); }
__device__ __forceinline__ int fresh_tid() { int t = threadIdx.x; asm volatile("" : "+v"(t)); return t; }
__device__ __forceinline__ float sigmoidf_(float x) { return __frcp_rn(1.0f + __expf(-x)); }
__device__ __forceinline__ void unpack8(const u32x4 v, float* f) { f[0] = bflo(v.x); f[1] = bfhi(v.x); f[2] = bflo(v.y); f[3] = bfhi(v.y); f[4] = bflo(v.z); f[5] = bfhi(v.z); f[6] = bflo(v.w); f[7] = bfhi(v.w); }
__device__ __forceinline__ u32x4 pack8(const float* f) { u32x4 w; w.x = cvt_pk_bf16(f[0], f[1]); w.y = cvt_pk_bf16(f[2], f[3]); w.z = cvt_pk_bf16(f[4], f[5]); w.w = cvt_pk_bf16(f[6], f[7]); return w; }

namespace pg8 {
constexpr int BM = 256, BK = 64, HALF = 128, HTB = HALF * BK * 2, STAGE_BYTES = 8 * HTB, NXCD = 8, WGM = 8;
__host__ __device__ __forceinline__ int lds_byte(int r, int c) { const int st = (r >> 4) * 2 + (c >> 5), rr = r & 15, cc = c & 31, ob = rr * 64 + cc * 2; return st * 1024 + (ob ^ (((ob >> 9) & 1) << 5)); }
__host__ __device__ __forceinline__ void stage_rc(int b, int& R, int& C) { const int st = b / 1024, sb = b % 1024, swz = sb ^ (((sb >> 9) & 1) << 5); R = (st >> 1) * 16 + swz / 64; C = (st & 1) * 32 + (swz % 64) / 2; }
__host__ __device__ __forceinline__ int perm32(int rho) { const int n = rho >> 4, i = rho & 15; return 8 * (i >> 2) + 4 * n + (i & 3); }

struct Unit { int pm, pn; const char* a; const char* b; };

template <class Epi, class Sched>
__device__ __forceinline__ void gemm_phase(LAS unsigned char* lds, const int K, const int lda, const Sched& S, const Epi& E) {
    const int tid = fresh_tid(), wid = __builtin_amdgcn_readfirstlane(tid >> 6), lane = tid & 63, wr = wid >> 2, wc = wid & 3, fr = lane & 15, fq = lane >> 4;
    const int nt = K / BK;
    unsigned voffA[2], voffB[2];
#pragma unroll
    for (int i = 0; i < 2; ++i) { int R, C; stage_rc(tid * 16 + i * 8192, R, C); const int Rb = Epi::PERM ? ((R & ~31) + perm32(R & 31)) : R;
        voffA[i] = (unsigned)(R * lda + C) * 2u; voffB[i] = (unsigned)(Rb * K + C) * 2u; }
    const size_t kstep = (size_t)(BK * 2);
    const size_t hstepA = (size_t)HALF * lda * 2, hstepB = (size_t)HALF * K * 2;
    const unsigned ldsw = (unsigned)wid * 1024u;
    const int aoff = lds_byte(wr * 64 + fr, fq * 8), boff = lds_byte(wc * 32 + fr, fq * 8);
#define PG8_SA(b, h) (((b) * 2 + (h)) * HTB)
#define PG8_SB(b, h) ((4 + (b) * 2 + (h)) * HTB)
#define PG8_STAGE(bufoff, gbase, voff) do { _Pragma("unroll") for (int _i = 0; _i < 2; ++_i) \
        __builtin_amdgcn_global_load_lds((const unsigned*)((const char*)(gbase) + (voff)[_i]), (LAS unsigned*)(lds + (bufoff) + ldsw + _i * 8192), 16, 0, 0); } while (0)
#define PG8_LDA(dst, b, h) do { _Pragma("unroll") for (int m = 0; m < 4; ++m) _Pragma("unroll") for (int k = 0; k < 2; ++k) dst[m][k] = *(const LAS bf16x8*)(lds + PG8_SA(b, h) + aoff + m * 2048 + k * 1024); } while (0)
#define PG8_LDB(dst, b, h) do { _Pragma("unroll") for (int n = 0; n < 2; ++n) _Pragma("unroll") for (int k = 0; k < 2; ++k) dst[n][k] = *(const LAS bf16x8*)(lds + PG8_SB(b, h) + boff + n * 2048 + k * 1024); } while (0)
#define PG8_MMA(ai, bj, At, Bt) do { __builtin_amdgcn_s_setprio(1); _Pragma("unroll") for (int m = 0; m < 4; ++m) _Pragma("unroll") for (int n = 0; n < 2; ++n) _Pragma("unroll") for (int k = 0; k < 2; ++k) \
        acc[ai][bj][m][n] = __builtin_amdgcn_mfma_f32_16x16x32_bf16(Bt[n][k], At[m][k], acc[ai][bj][m][n], 0, 0, 0); __builtin_amdgcn_s_setprio(0); } while (0)
#define PG8_WAIT_V(n) asm volatile("s_waitcnt vmcnt(" #n ")" ::: "memory")
#define PG8_WAIT_L(n) asm volatile("s_waitcnt lgkmcnt(" #n ")" ::: "memory")
#define PG8_BAR __builtin_amdgcn_s_barrier()
#define PG8_SCHED __builtin_amdgcn_sched_barrier(0)
    Unit cur, nxt; int ui = 0;
    if (!S.next(0, cur)) return;
    f32x4 acc[2][2][4][2];
#pragma unroll
    for (int a = 0; a < 2; ++a)
#pragma unroll
        for (int b = 0; b < 2; ++b)
#pragma unroll
            for (int m = 0; m < 4; ++m)
#pragma unroll
                for (int n = 0; n < 2; ++n) acc[a][b][m][n] = (f32x4){0.f, 0.f, 0.f, 0.f};
    bf16x8 At[4][2], B0[2][2], B1[2][2];
    const char* cA = cur.a; const char* cB = cur.b;
    PG8_STAGE(PG8_SB(0, 0), cB, voffB); PG8_STAGE(PG8_SB(0, 1), cB + hstepB, voffB); PG8_STAGE(PG8_SA(0, 0), cA, voffA); PG8_STAGE(PG8_SA(0, 1), cA + hstepA, voffA);
    if (wr == 1) PG8_BAR;
    PG8_WAIT_V(2); PG8_BAR;
    PG8_STAGE(PG8_SB(1, 0), cB + kstep, voffB); PG8_STAGE(PG8_SA(1, 0), cA + kstep, voffA); PG8_STAGE(PG8_SB(1, 1), cB + hstepB + kstep, voffB);
    PG8_WAIT_V(6); PG8_BAR;
    for (;;) {
        const bool has_next = S.next(ui + 1, nxt);
        const char* nA = has_next ? nxt.a : cA; const char* nB = has_next ? nxt.b : cB;
        for (int t = 0; t < nt; t += 2) {
            const bool last = (t == nt - 2);
            const char* a1 = cA + (size_t)(t + 1) * kstep;
            const char* a2 = last ? nA : cA + (size_t)(t + 2) * kstep; const char* b2 = last ? nB : cB + (size_t)(t + 2) * kstep;
            const char* a3 = a2 + kstep; const char* b3 = b2 + kstep;
            PG8_LDB(B0, 0, 0); PG8_LDB(B1, 0, 1); PG8_SCHED; PG8_LDA(At, 0, 0); PG8_STAGE(PG8_SA(1, 1), a1 + hstepA, voffA);
            PG8_WAIT_V(8); PG8_WAIT_L(0); PG8_BAR; PG8_MMA(0, 0, At, B0); PG8_MMA(0, 1, At, B1); PG8_BAR; PG8_SCHED;
            PG8_LDA(At, 0, 1); PG8_STAGE(PG8_SB(0, 0), b2, voffB); PG8_STAGE(PG8_SB(0, 1), b2 + hstepB, voffB); PG8_STAGE(PG8_SA(0, 0), a2, voffA);
            PG8_WAIT_V(8); PG8_WAIT_L(0); PG8_BAR; PG8_MMA(1, 0, At, B0); PG8_MMA(1, 1, At, B1); PG8_BAR; PG8_SCHED;
            PG8_LDB(B0, 1, 0); PG8_LDB(B1, 1, 1); PG8_SCHED; PG8_LDA(At, 1, 0); PG8_STAGE(PG8_SA(0, 1), a2 + hstepA, voffA);
            PG8_WAIT_V(8); PG8_WAIT_L(0); PG8_BAR; PG8_MMA(0, 0, At, B0); PG8_MMA(0, 1, At, B1); PG8_BAR; PG8_SCHED;
            PG8_LDA(At, 1, 1); PG8_STAGE(PG8_SB(1, 0), b3, voffB); PG8_STAGE(PG8_SB(1, 1), b3 + hstepB, voffB); PG8_STAGE(PG8_SA(1, 0), a3, voffA);
            PG8_WAIT_V(8); PG8_WAIT_L(0); PG8_BAR; PG8_MMA(1, 0, At, B0); PG8_MMA(1, 1, At, B1); PG8_BAR; PG8_SCHED;
        }
        E(acc, cur, wr, wc, fr, fq);
        if (!has_next) break;
#pragma unroll
        for (int a = 0; a < 2; ++a)
#pragma unroll
            for (int b = 0; b < 2; ++b)
#pragma unroll
                for (int m = 0; m < 4; ++m)
#pragma unroll
                    for (int n = 0; n < 2; ++n) acc[a][b][m][n] = (f32x4){0.f, 0.f, 0.f, 0.f};
        cur = nxt; cA = nA; cB = nB; ++ui;
    }
    PG8_WAIT_V(0);
    if (wr == 0) PG8_BAR;
    PG8_BAR;
#undef PG8_SA
#undef PG8_SB
#undef PG8_STAGE
#undef PG8_LDA
#undef PG8_LDB
#undef PG8_MMA
#undef PG8_WAIT_V
#undef PG8_WAIT_L
#undef PG8_BAR
#undef PG8_SCHED
}

struct TileOrder {
    int nM, nN, nwg, G, c; const char* A; const char* Bt; size_t tA, tB;
    __device__ void init(int M, int N, int K, int lda, int G_, int c_, const void* A_, const void* Bt_) { nM = M / BM; nN = N / BM; nwg = nM * nN; G = G_; c = c_; A = (const char*)A_; Bt = (const char*)Bt_; tA = (size_t)BM * lda * 2; tB = (size_t)BM * K * 2; }
    __device__ bool next(int i, Unit& u) const {
        const long L = (long)i * G + c; if (L >= nwg) return false;
        int wgid = (int)L; { const int q = nwg / NXCD, r = nwg % NXCD, xcd = wgid % NXCD, off = wgid / NXCD; wgid = (xcd < r ? xcd * (q + 1) : r * (q + 1) + (xcd - r) * q) + off; }
        const int nig = WGM * nN, gid = wgid / nig, fm = gid * WGM, gsz = (nM - fm) < WGM ? (nM - fm) : WGM;
        u.pm = fm + ((wgid % nig) % gsz); u.pn = (wgid % nig) / gsz; u.a = A + (size_t)u.pm * tA; u.b = Bt + (size_t)u.pn * tB; return true;
    }
};
template <int TYPE> struct QkvOrder {
    int G, c; const char* A; const char* W;
    __device__ bool next(int i, Unit& u) const {
        const int L = i * G + c; if (L >= 68 * 4) return false;
        u.pm = L >> 2; u.pn = L & 3;
        u.a = A + ((size_t)u.pm * 256 * 1024 + u.pn * 256) * 2; u.b = W + (size_t)u.pn * 256 * 256 * 2; return true;
    }
};

struct EpiProj {
    static constexpr bool PERM = true;
    unsigned char* ws; const float* lbp;
    __device__ __forceinline__ void operator()(const f32x4 (&acc)[2][2][4][2], const Unit& u, int wr, int wc, int fr, int fq) const {
        const int ub = u.pn >> 2;
        bf16_t* base = (bf16_t*)(ws + (size_t)ub * UB);
        const int row0 = u.pm * BM + wr * 64 + fr, col0 = (u.pn & 3) * 256 + wc * 32 + 8 * fq;
        const int mode = (u.pm < 64) ? (ub == 3 ? 1 : (ub == 4 ? 2 : 0)) : 0;
        float lb[2][8];
        if (mode == 1) {
#pragma unroll
            for (int bj = 0; bj < 2; ++bj)
#pragma unroll
                for (int e = 0; e < 8; ++e) { const int c = col0 + bj * HALF + e; lb[bj][e] = __frcp_rn(1.0f + __expf(lbp[1024 + c] - lbp[c])); }
        }
#pragma unroll
        for (int ai = 0; ai < 2; ++ai)
#pragma unroll
            for (int m = 0; m < 4; ++m) { bf16_t* rowp = base + (size_t)(row0 + ai * HALF + m * 16) * 1024 + col0;
#pragma unroll
                for (int bj = 0; bj < 2; ++bj) { float v[8];
#pragma unroll
                    for (int e = 0; e < 4; ++e) { v[e] = acc[ai][bj][m][0][e]; v[4 + e] = acc[ai][bj][m][1][e]; }
                    if (mode == 1) {
#pragma unroll
                        for (int e = 0; e < 8; ++e) v[e] = __logf(lb[bj][e] + (1.0f - lb[bj][e]) * sigmoidf_(v[e]));
                    } else if (mode == 2) {
#pragma unroll
                        for (int e = 0; e < 8; ++e) v[e] = v[e] * sigmoidf_(v[e]);
                    }
                    *(u32x4*)(rowp + bj * HALF) = pack8(v); } }
    }
};
template <int TYPE> struct EpiQkv {
    static constexpr bool PERM = true;
    bf16_t* o;
    __device__ __forceinline__ void operator()(const f32x4 (&acc)[2][2][4][2], const Unit& u, int wr, int wc, int fr, int fq) const {
        constexpr int ld = TYPE ? 1024 : 512; constexpr size_t bjoff = TYPE ? 128 : (UB / 4);
        bf16_t* base = o + u.pn * (TYPE ? 256 : 128) + (size_t)(u.pm * BM + wr * 64 + fr) * ld + wc * 32 + 8 * fq;
#pragma unroll
        for (int ai = 0; ai < 2; ++ai)
#pragma unroll
            for (int m = 0; m < 4; ++m) { bf16_t* rowp = base + (size_t)(ai * HALF + m * 16) * ld;
#pragma unroll
                for (int bj = 0; bj < 2; ++bj) { const f32x4 v0 = acc[ai][bj][m][0], v1 = acc[ai][bj][m][1];
                    u32x4 w; w.x = cvt_pk_bf16(v0[0], v0[1]); w.y = cvt_pk_bf16(v0[2], v0[3]); w.z = cvt_pk_bf16(v1[0], v1[1]); w.w = cvt_pk_bf16(v1[2], v1[3]);
                    *(u32x4*)(rowp + bj * bjoff) = w; } }
    }
};
struct EpiOut {
    static constexpr bool PERM = false;
    float* y; const float* xp; const float* xs;
    __device__ __forceinline__ void operator()(const f32x4 (&acc)[2][2][4][2], const Unit& u, int wr, int wc, int fr, int fq) const {
        const int row0 = u.pm * BM + wr * 64 + fr, col0 = u.pn * BM + wc * 32 + 4 * fq;
        const float* xb = (u.pm < 64) ? xp : (xs - (size_t)NROWS_P * 1024);
#pragma unroll
        for (int ai = 0; ai < 2; ++ai)
#pragma unroll
            for (int m = 0; m < 4; ++m) { const size_t ro = (size_t)(row0 + ai * HALF + m * 16) * 1024 + col0;
#pragma unroll
                for (int bj = 0; bj < 2; ++bj)
#pragma unroll
                    for (int n = 0; n < 2; ++n) { const f32x4 xv = *(const f32x4*)(xb + ro + bj * HALF + n * 16); *(f32x4*)(y + ro + bj * HALF + n * 16) = acc[ai][bj][m][n] + xv; } }
    }
};
}

__device__ __forceinline__ float wave_sum(float v) {
#pragma unroll
    for (int o = 32; o >= 1; o >>= 1) v += __shfl_xor(v, o);
    return v;
}

__device__ __forceinline__ void tr_tile(LAS float* tile, const float* __restrict__ src, int ld_src, bf16_t* __restrict__ dst, int ld_dst, int r0, int c0) {
    const int tid = threadIdx.x;
    { const int tr = tid >> 4, tc = (tid & 15) * 4;
#pragma unroll
      for (int i = 0; i < 2; ++i) { const int r = tr + 32 * i; const f32x4 v = *(const f32x4*)(src + (size_t)(r0 + r) * ld_src + c0 + tc);
          tile[r * 65 + tc] = v[0]; tile[r * 65 + tc + 1] = v[1]; tile[r * 65 + tc + 2] = v[2]; tile[r * 65 + tc + 3] = v[3]; } }
    __syncthreads();
    { const int c = tid >> 3, rg = (tid & 7) * 8; float f[8];
#pragma unroll
      for (int j = 0; j < 8; ++j) f[j] = tile[(rg + j) * 65 + c];
      *(u32x4*)(dst + (size_t)(c0 + c) * ld_dst + r0 + rg) = pack8(f); }
    __syncthreads();
}

__device__ __forceinline__ void phase_prep(const Params& p, LAS unsigned char* lds) {
    LAS float* tile = (LAS float*)lds;
    bf16_t* winT = (bf16_t*)((unsigned char*)p.out + YS_WIN);
    bf16_t* woutT = (bf16_t*)(p.ws + WS_WOUT);
    bf16_t* wqkT = (bf16_t*)(p.ws + WS_WQK);
    bf16_t* wvT = (bf16_t*)(p.ws + WS_WV);
    bf16_t* xn = (bf16_t*)((unsigned char*)p.out + YS_XN);
    constexpr int T_WIN = 16 * 112, T_WOUT = 32 * 16, T_WQ = 32, T_WK = 32, T_WV = 64;
    constexpr int T_ALL = T_WIN + T_WOUT + T_WQ + T_WK + T_WV, XN_GROUPS = NROWS / 8;
    for (int w = blockIdx.x; w < T_ALL + XN_GROUPS; w += gridDim.x) {
        if (w < T_ALL) {
            int t = w;
            if (t < T_WIN) { tr_tile(tile, p.w_in, 7168, winT, 1024, (t & 15) * 64, (t >> 4) * 64); continue; }
            t -= T_WIN;
            if (t < T_WOUT) { tr_tile(tile, p.w_out, 1024, woutT, 2048, (t & 31) * 64, (t >> 5) * 64); continue; }
            t -= T_WOUT;
            if (t < T_WQ) { const int h = t >> 3, tt = t & 7; tr_tile(tile, p.w_q + (size_t)h * 256 * 128, 128, wqkT + (size_t)h * 65536, 256, (tt & 3) * 64, (tt >> 2) * 64); continue; }
            t -= T_WQ;
            if (t < T_WK) { const int h = t >> 3, tt = t & 7; tr_tile(tile, p.w_k + (size_t)h * 256 * 128, 128, wqkT + (size_t)h * 65536 + 128 * 256, 256, (tt & 3) * 64, (tt >> 2) * 64); continue; }
            t -= T_WK;
            { const int h = t >> 4, tt = t & 15; tr_tile(tile, p.w_v + (size_t)h * 65536, 256, wvT + (size_t)h * 65536, 256, (tt & 3) * 64, (tt >> 2) * 64); }
        } else {
            const int r = (w - T_ALL) * 8 + (threadIdx.x >> 6), lane = threadIdx.x & 63;
            const float* src = (r < NROWS_P) ? p.x_prompt + (size_t)r * 1024 : p.x_sample + (size_t)(r - NROWS_P) * 1024;
            f32x4 v[4]; float ss = 0.f;
#pragma unroll
            for (int i = 0; i < 4; ++i) { v[i] = *(const f32x4*)(src + lane * 4 + 256 * i); ss += v[i][0] * v[i][0] + v[i][1] * v[i][1] + v[i][2] * v[i][2] + v[i][3] * v[i][3]; }
            ss = wave_sum(ss);
            const float rstd = rsqrtf(ss * (1.0f / 1024.0f) + 1e-6f);
#pragma unroll
            for (int i = 0; i < 4; ++i) { const f32x4 g = *(const f32x4*)(p.g_norm + lane * 4 + 256 * i);
                u32x2 w; w.x = cvt_pk_bf16(v[i][0] * rstd * g[0], v[i][1] * rstd * g[1]); w.y = cvt_pk_bf16(v[i][2] * rstd * g[2], v[i][3] * rstd * g[3]);
                *(u32x2*)(xn + (size_t)r * 1024 + lane * 4 + 256 * i) = w; }
        }
    }
}

__device__ __forceinline__ void phase_conv(const Params& p) {
    const bf16_t* xm = (const bf16_t*)(p.ws + WS_U0);
    bf16_t* xc = (bf16_t*)((unsigned char*)p.out + YS_XC);
    const int nthreads = gridDim.x * blockDim.x;
    for (int idx = blockIdx.x * blockDim.x + fresh_tid(); idx < NROWS * 128; idx += nthreads) {
        const int r = idx >> 7, c0 = (idx & 127) * 8;
        int b, t; const bool samp = r >= NROWS_P;
        if (!samp) { b = r >> 11; t = r & 2047; } else { b = (r - NROWS_P) >> 3; t = (r - NROWS_P) & 7; }
        float accv[8];
        { const f32x4 b0 = *(const f32x4*)(p.conv_b + c0), b1 = *(const f32x4*)(p.conv_b + c0 + 4);
          accv[0] = b0[0]; accv[1] = b0[1]; accv[2] = b0[2]; accv[3] = b0[3]; accv[4] = b1[0]; accv[5] = b1[1]; accv[6] = b1[2]; accv[7] = b1[3]; }
        float cur[8];
#pragma unroll
        for (int j = 0; j < 4; ++j) {
            const int tt = t - 3 + j; float xv[8];
            if (tt >= 0) { unpack8(*(const u32x4*)(xm + (size_t)(r - 3 + j) * 1024 + c0), xv); }
            else if (samp) { const float* s = p.st_conv + ((size_t)b * 3 + (t + j)) * 1024 + c0; const f32x4 s0 = *(const f32x4*)s, s1 = *(const f32x4*)(s + 4);
                xv[0] = s0[0]; xv[1] = s0[1]; xv[2] = s0[2]; xv[3] = s0[3]; xv[4] = s1[0]; xv[5] = s1[1]; xv[6] = s1[2]; xv[7] = s1[3]; }
            else {
#pragma unroll
                for (int e = 0; e < 8; ++e) xv[e] = 0.f; }
            const f32x4 w0 = *(const f32x4*)(p.conv_w + j * 1024 + c0), w1 = *(const f32x4*)(p.conv_w + j * 1024 + c0 + 4);
            accv[0] += w0[0] * xv[0]; accv[1] += w0[1] * xv[1]; accv[2] += w0[2] * xv[2]; accv[3] += w0[3] * xv[3];
            accv[4] += w1[0] * xv[4]; accv[5] += w1[1] * xv[5]; accv[6] += w1[2] * xv[6]; accv[7] += w1[3] * xv[7];
            if (j == 3) {
#pragma unroll
                for (int e = 0; e < 8; ++e) cur[e] = xv[e]; }
        }
#pragma unroll
        for (int e = 0; e < 8; ++e) accv[e] = accv[e] * sigmoidf_(accv[e]);
        *(u32x4*)(xc + (size_t)r * 1024 + c0) = pack8(accv);
        float* cdst = nullptr;
        if (!samp) { if (t >= 2045) cdst = p.out + O_PCONV + ((size_t)b * 3 + (t - 2045)) * 1024 + c0; }
        else { if (t >= 5) cdst = p.out + O_SCONV + ((size_t)b * 3 + (t - 5)) * 1024 + c0; }
        if (cdst) { *(f32x4*)cdst = (f32x4){cur[0], cur[1], cur[2], cur[3]}; *(f32x4*)(cdst + 4) = (f32x4){cur[4], cur[5], cur[6], cur[7]}; }
    }
}

__device__ __forceinline__ void phase_gates(const Params& p, LAS unsigned char* lds) {
    LAS f32x4* wgA = (LAS f32x4*)lds;
    LAS f32x4* wgB = wgA + 2048;
    for (int i = threadIdx.x; i < 2048; i += blockDim.x) {
        const f32x4 a = *(const f32x4*)(p.w_gate + (size_t)i * 8), b = *(const f32x4*)(p.w_gate + (size_t)i * 8 + 4);
        const int slot = (i & 7) * 256 + (i >> 3); wgA[slot] = a; wgB[slot] = b; }
    __syncthreads();
    const bf16_t* q = (const bf16_t*)((unsigned char*)p.out + YS_Q);
    const bf16_t* k = (const bf16_t*)((unsigned char*)p.out + YS_K);
    const bf16_t* v = (const bf16_t*)(p.ws + WS_U0);
    float* gates = (float*)(p.ws + WS_GATES);
    const int tid = fresh_tid(), lane = tid & 63, wave = blockIdx.x * 8 + (tid >> 6), nw = gridDim.x * 8;
    for (int r = wave; r < NROWS; r += nw) {
        u32x4 d[4];
        d[0] = *(const u32x4*)(q + (size_t)r * 512 + lane * 8); d[1] = *(const u32x4*)(k + (size_t)r * 512 + lane * 8);
        d[2] = *(const u32x4*)(v + (size_t)r * 1024 + lane * 8); d[3] = *(const u32x4*)(v + (size_t)r * 1024 + 512 + lane * 8);
        f32x4 ga = (f32x4){0.f, 0.f, 0.f, 0.f}, gb = ga;
#pragma unroll 1
        for (int c = 0; c < 4; ++c) { float f[8]; unpack8(d[c], f);
#pragma unroll
            for (int j = 0; j < 8; ++j) { const int slot = j * 256 + c * 64 + lane; ga += wgA[slot] * f[j]; gb += wgB[slot] * f[j]; } }
        float g8[8] = {ga[0], ga[1], ga[2], ga[3], gb[0], gb[1], gb[2], gb[3]};
#pragma unroll
        for (int j = 0; j < 8; ++j) g8[j] = wave_sum(g8[j]);
        if (lane < 8) {
            float val = g8[0];
#pragma unroll
            for (int j = 1; j < 8; ++j) val = (lane == j) ? g8[j] : val;
            val += p.b_gate[lane];
            if (lane >= 4) val = fminf(val, 0.f) - __logf(1.0f + __expf(-fabsf(val)));
            gates[(size_t)r * 8 + lane] = val;
        }
    }
    __syncthreads();
}

__device__ __forceinline__ void phase_post(const Params& p) {
    const bf16_t* num = (const bf16_t*)(p.ws + WS_U0);
    const bf16_t* zm = (const bf16_t*)(p.ws + WS_U0 + UB);
    const bf16_t* om = (const bf16_t*)(p.ws + WS_U0 + 2 * UB);
    const bf16_t* oh = (const bf16_t*)(p.ws + WS_U0 + 5 * UB);
    const bf16_t* zh = (const bf16_t*)(p.ws + WS_U0 + 6 * UB);
    const bf16_t* xc = (const bf16_t*)((unsigned char*)p.out + YS_XC);
    bf16_t* mix = (bf16_t*)(p.ws + WS_U0 + 3 * UB);
    const float* den = (const float*)(p.ws + WS_DEN);
    const float* mt = (const float*)(p.ws + WS_MT);
    const int tid = fresh_tid(), lane = tid & 63, wave = blockIdx.x * 8 + (tid >> 6), nw = gridDim.x * 8;
    const int c0 = lane * 16;
    for (int r = wave; r < NROWS; r += nw) {
        {
            const int h = lane >> 4;
            float x[16], t[16];
            unpack8(*(const u32x4*)(num + (size_t)r * 1024 + c0), x); unpack8(*(const u32x4*)(num + (size_t)r * 1024 + c0 + 8), x + 8);
            const float dn = den[(size_t)r * 4 + h], m = mt[(size_t)r * 4 + h];
            const float inv = __frcp_rn(fmaxf(fabsf(dn), __expf(-m)));
            float s = 0.f;
#pragma unroll
            for (int j = 0; j < 16; ++j) { x[j] *= inv; s += x[j]; }
            s += __shfl_xor(s, 1); s += __shfl_xor(s, 2); s += __shfl_xor(s, 4); s += __shfl_xor(s, 8);
            const float mu = s * (1.0f / 256.0f);
            float vs = 0.f;
#pragma unroll
            for (int j = 0; j < 16; ++j) { x[j] -= mu; vs += x[j] * x[j]; }
            vs += __shfl_xor(vs, 1); vs += __shfl_xor(vs, 2); vs += __shfl_xor(vs, 4); vs += __shfl_xor(vs, 8);
            const float rstd = rsqrtf(vs * (1.0f / 256.0f) + 1e-6f);
            unpack8(*(const u32x4*)(om + (size_t)r * 1024 + c0), t); unpack8(*(const u32x4*)(om + (size_t)r * 1024 + c0 + 8), t + 8);
#pragma unroll
            for (int j = 0; j < 16; ++j) x[j] = x[j] * rstd * p.m_ln[c0 + j] * sigmoidf_(t[j]);
            unpack8(*(const u32x4*)(xc + (size_t)r * 1024 + c0), t); unpack8(*(const u32x4*)(xc + (size_t)r * 1024 + c0 + 8), t + 8);
#pragma unroll
            for (int j = 0; j < 16; ++j) x[j] += p.m_skip[c0 + j] * t[j];
            unpack8(*(const u32x4*)(zm + (size_t)r * 1024 + c0), t); unpack8(*(const u32x4*)(zm + (size_t)r * 1024 + c0 + 8), t + 8);
#pragma unroll
            for (int j = 0; j < 16; ++j) x[j] *= t[j] * sigmoidf_(t[j]);
            *(u32x4*)(mix + (size_t)r * 2048 + c0) = pack8(x); *(u32x4*)(mix + (size_t)r * 2048 + c0 + 8) = pack8(x + 8);
        }
        {
            float x[16], t[16];
            unpack8(*(const u32x4*)(oh + (size_t)r * 1024 + c0), x); unpack8(*(const u32x4*)(oh + (size_t)r * 1024 + c0 + 8), x + 8);
            float s = 0.f;
#pragma unroll
            for (int j = 0; j < 16; ++j) s += x[j] * x[j];
            s += __shfl_xor(s, 1); s += __shfl_xor(s, 2); s += __shfl_xor(s, 4);
            const float rstd = rsqrtf(s * (1.0f / 128.0f) + 1e-6f);
            unpack8(*(const u32x4*)(zh + (size_t)r * 1024 + c0), t); unpack8(*(const u32x4*)(zh + (size_t)r * 1024 + c0 + 8), t + 8);
#pragma unroll
            for (int j = 0; j < 16; ++j) x[j] = x[j] * rstd * p.h_norm[c0 + j] * t[j] * sigmoidf_(t[j]);
            *(u32x4*)(mix + (size_t)r * 2048 + 1024 + c0) = pack8(x); *(u32x4*)(mix + (size_t)r * 2048 + 1024 + c0 + 8) = pack8(x + 8);
        }
    }
}

__device__ __forceinline__ void phase_final(const Params& p) {
    float* y = p.out + O_Y;
    const int tid = fresh_tid(), lane = tid & 63, wave = blockIdx.x * 8 + (tid >> 6), nw = gridDim.x * 8;
    for (int r = wave; r < NROWS; r += nw) {
        f32x4 v[4]; float ss = 0.f;
#pragma unroll
        for (int i = 0; i < 4; ++i) { v[i] = *(const f32x4*)(y + (size_t)r * 1024 + lane * 4 + 256 * i); ss += v[i][0] * v[i][0] + v[i][1] * v[i][1] + v[i][2] * v[i][2] + v[i][3] * v[i][3]; }
        ss = wave_sum(ss);
        const float rstd = rsqrtf(ss * (1.0f / 1024.0f) + 1e-6f);
#pragma unroll
        for (int i = 0; i < 4; ++i) { const f32x4 g = *(const f32x4*)(p.g_final + lane * 4 + 256 * i);
            *(f32x4*)(y + (size_t)r * 1024 + lane * 4 + 256 * i) = v[i] * rstd * g; }
    }
}

constexpr int QS = 272, K2S = 320, VS = 192, PS = 144;
constexpr int OFF_Q1 = 0, OFF_Q2 = 17408, OFF_KX = 34816, OFF_K2 = 52224, OFF_V = 72704, OFF_P = 84992, OFF_CT = 94208, OFF_VEC = 120320, OFF_B = 123392, OFF_TOT = 156160;
#define MFMA32(a, b, c) __builtin_amdgcn_mfma_f32_32x32x16_bf16((a), (b), (c), 0, 0, 0)
__device__ __forceinline__ int crow(int reg, int lane) { return (reg & 3) + 8 * (reg >> 2) + 4 * (lane >> 5); }
typedef short s16x4 __attribute__((ext_vector_type(4)));
__device__ __forceinline__ bf16x8 tr_frag(unsigned a0, unsigned a1) {
    s16x4 lo, hi;
    asm volatile("ds_read_b64_tr_b16 %0, %2\n\tds_read_b64_tr_b16 %1, %3\n\ts_waitcnt lgkmcnt(0)" : "=&v"(lo), "=&v"(hi) : "v"(a0), "v"(a1) : "memory");
    return (bf16x8){lo[0], lo[1], lo[2], lo[3], hi[0], hi[1], hi[2], hi[3]};
}

__device__ __forceinline__ void tr_frag4(const unsigned a0, const int S, bf16x8 (&f)[4]) {
    s16x4 r0, r1, r2, r3, r4, r5, r6, r7;
    const unsigned a1 = a0 + 4 * S, a2 = a0 + 16 * S, a3 = a0 + 20 * S, a4 = a0 + 32 * S, a5 = a0 + 36 * S, a6 = a0 + 48 * S, a7 = a0 + 52 * S;
    asm volatile("ds_read_b64_tr_b16 %0, %8\n\tds_read_b64_tr_b16 %1, %9\n\tds_read_b64_tr_b16 %2, %10\n\tds_read_b64_tr_b16 %3, %11\n\t"
                 "ds_read_b64_tr_b16 %4, %12\n\tds_read_b64_tr_b16 %5, %13\n\tds_read_b64_tr_b16 %6, %14\n\tds_read_b64_tr_b16 %7, %15\n\ts_waitcnt lgkmcnt(0)"
                 : "=&v"(r0), "=&v"(r1), "=&v"(r2), "=&v"(r3), "=&v"(r4), "=&v"(r5), "=&v"(r6), "=&v"(r7)
                 : "v"(a0), "v"(a1), "v"(a2), "v"(a3), "v"(a4), "v"(a5), "v"(a6), "v"(a7) : "memory");
    f[0] = (bf16x8){r0[0], r0[1], r0[2], r0[3], r1[0], r1[1], r1[2], r1[3]}; f[1] = (bf16x8){r2[0], r2[1], r2[2], r2[3], r3[0], r3[1], r3[2], r3[3]};
    f[2] = (bf16x8){r4[0], r4[1], r4[2], r4[3], r5[0], r5[1], r5[2], r5[3]}; f[3] = (bf16x8){r6[0], r6[1], r6[2], r6[3], r7[0], r7[1], r7[2], r7[3]};
}

template <int NT, bool IS_M>
__device__ __forceinline__ void scan_item(const Params& p, LAS unsigned char* lds, const int b, const int h, const int sl) {
    const int tid = fresh_tid(), wid = __builtin_amdgcn_readfirstlane(tid >> 6), lane = tid & 63, l31 = lane & 31, lh = lane >> 5;
    constexpr int nch = 32; const int row0 = b * 2048;
    LAS float* vec = (LAS float*)(lds + OFF_VEC);
    const unsigned ldsb = (unsigned)(size_t)lds;
    const bf16_t* gq; const bf16_t* gk; bf16_t* gv; int ldq; constexpr int ldv = 1024;
    if (IS_M) { gq = (const bf16_t*)((unsigned char*)p.out + YS_Q) + h * 128; gk = (const bf16_t*)((unsigned char*)p.out + YS_K) + h * 128; ldq = 512;
                gv = (bf16_t*)(p.ws + WS_U0) + h * 256 + sl * 64; }
    else { gq = (const bf16_t*)(p.ws + WS_U0 + 4 * UB) + h * 128; gk = (const bf16_t*)(p.ws + WS_U0 + 3 * UB) + h * 128; ldq = 1024;
           gv = (bf16_t*)(p.ws + WS_U0 + 5 * UB) + h * 128 + sl * 64; }
    const float* gates = (const float*)(p.ws + WS_GATES);
    const int kc = (tid & 15) * 8, tq = tid >> 4;
    const int dc = (tid & 7) * 8, tv = tid >> 3;
    const int trow = 8 * lh + ((lane & 15) >> 2), tcolb = (16 * ((lane >> 4) & 1) + 4 * (lane & 3)) * 2;
    if (!IS_M) { if (tid < 128) { const float p0 = p.lb_param[h * 128 + tid], p1 = p.lb_param[1024 + h * 128 + tid]; const float lb = __frcp_rn(1.0f + __expf(p1 - p0)); vec[384 + tid] = lb; vec[512 + tid] = 1.0f - lb; } }
    f32x16 st[NT];
#pragma unroll
    for (int j = 0; j < NT; ++j)
#pragma unroll
        for (int r = 0; r < 16; ++r) st[j][r] = 0.f;
    for (int i = tid; i < NT * 32 * QS / 16; i += 512) *(LAS u32x4*)(lds + OFF_CT + i * 16) = (u32x4){0u, 0u, 0u, 0u};
    if (IS_M) {
        if (tid < 64) { unsigned one = 0x3F80u; asm volatile("" : "+v"(one));
#pragma unroll
            for (int i = 0; i < 4; ++i) *(LAS u32x4*)(lds + OFF_V + tid * VS + 128 + 16 * i) = (u32x4){(i == 0) ? one : 0u, 0u, 0u, 0u}; }
    }
    LAS unsigned char* outb = lds + (IS_M ? OFF_B : OFF_CT + 64 * QS);
    LAS float* glds = (LAS float*)(lds + OFF_B + 8192); LAS float* dmt = (LAS float*)(lds + OFF_B + 8192 + 16384);
    if (IS_M) { for (int i = tid; i < 2048; i += 512) { const size_t gr = (size_t)(row0 + i) * 8; glds[2 * i] = gates[gr + h]; glds[2 * i + 1] = gates[gr + 4 + h]; } }
    __syncthreads();
    float m_run = 0.f;
    auto gate_vectors = [&](const int c) {
        LAS float* vb = vec + (c & 1) * 320;
        const float ig = glds[2 * (c * 64 + lane)], lf = glds[2 * (c * 64 + lane) + 1];
        float bc = lf;
#pragma unroll
        for (int o = 1; o < 64; o <<= 1) { const float u = __shfl_up(bc, o); if (lane >= o) bc += u; }
        const float a = ig - bc;
        float M = fmaxf(a, m_run);
#pragma unroll
        for (int o = 1; o < 64; o <<= 1) { const float u = __shfl_up(M, o); if (lane >= o) M = fmaxf(M, u); }
        const float M63 = __shfl(M, 63), b63 = __shfl(bc, 63);
        vb[lane] = a; vb[64 + lane] = M; vb[128 + lane] = __expf(M63 - M) * 0.08838834764831845f; vb[192 + lane] = __expf(a - M63);
        if (lane == 0) vb[256] = __expf(m_run - M63);
        vb[257 + lane] = bc + M;
        m_run = b63 + M63;
    };
    if (IS_M && wid == 7) gate_vectors(0);
    u32x4 rq[2], rk[2], rv;
#pragma unroll
    for (int i = 0; i < 2; ++i) { const unsigned ro = (unsigned)((row0 + tq + 32 * i) * ldq + kc); rq[i] = *(const u32x4*)(gq + ro); rk[i] = *(const u32x4*)(gk + ro); }
    rv = *(const u32x4*)(gv + (unsigned)((row0 + tv) * ldv + dc));
    __syncthreads();

#pragma unroll 1
    for (int c = 0; c < nch; ++c) {
        const int t0 = c * 64;
        const int tidc = fresh_tid(), kc = (tidc & 15) * 8, tq = tidc >> 4, dc = (tidc & 7) * 8, tv = tidc >> 3;
        LAS float* vb = vec + (c & 1) * 320;
        if (IS_M) {
#pragma unroll
            for (int i = 0; i < 2; ++i) { const int t = tq + 32 * i; float f[8], g[8];
                *(LAS u32x4*)(lds + OFF_KX + t * QS + kc * 2) = rk[i];
                unpack8(rq[i], f); const float gs = vb[128 + t];
#pragma unroll
                for (int j = 0; j < 8; ++j) g[j] = f[j] * gs;
                *(LAS u32x4*)(lds + OFF_Q1 + t * QS + kc * 2) = pack8(g);
                unpack8(rk[i], f); const float ws_ = vb[192 + t];
#pragma unroll
                for (int j = 0; j < 8; ++j) g[j] = f[j] * ws_;
                *(LAS u32x4*)(lds + OFF_K2 + t * K2S + kc * 2) = pack8(g);
            }
        } else {
            LAS float* Bf = (LAS float*)(lds + OFF_B); LAS float* tot = (LAS float*)(lds + OFF_TOT);
#pragma unroll
            for (int i = 0; i < 2; ++i) { const int t = tq + 32 * i; float f[8]; unpack8(rk[i], f);
                *(LAS f32x4*)(Bf + t * 128 + kc) = (f32x4){f[0], f[1], f[2], f[3]}; *(LAS f32x4*)(Bf + t * 128 + kc + 4) = (f32x4){f[4], f[5], f[6], f[7]}; }
            __syncthreads();
            { const int k = tid & 127, seg = tid >> 7; float run = 0.f;
#pragma unroll
              for (int t = 0; t < 16; ++t) { run += Bf[(seg * 16 + t) * 128 + k]; Bf[(seg * 16 + t) * 128 + k] = run; }
              tot[seg * 128 + k] = run; }
            __syncthreads();
            float t0s[8], t1s[8], t2s[8], bmid[8], blast[8];
#pragma unroll
            for (int j = 0; j < 8; ++j) { const int k = kc + j; t0s[j] = tot[k]; t1s[j] = tot[128 + k]; t2s[j] = tot[256 + k]; bmid[j] = Bf[31 * 128 + k] + t0s[j]; blast[j] = Bf[63 * 128 + k] + t0s[j] + t1s[j] + t2s[j]; }
            const bool hiseg = (tq >= 16);
#pragma unroll
            for (int i = 0; i < 2; ++i) { const int t = tq + 32 * i; float fq[8], ff[8], q1[8], q2[8], kx[8], k2[8];
                unpack8(rq[i], fq); unpack8(rk[i], ff);
#pragma unroll
                for (int j = 0; j < 8; ++j) {
                    const float pre = (i == 0) ? (hiseg ? t0s[j] : 0.f) : (hiseg ? t0s[j] + t1s[j] + t2s[j] : t0s[j] + t1s[j]);
                    const float bb = Bf[t * 128 + kc + j] + pre;
                    const float qv = fq[j], kv = 1.0f - __expf(ff[j]);
                    q1[j] = qv * __expf(bb - bmid[j]); q2[j] = qv * __expf(bb); kx[j] = kv * __expf(bmid[j] - bb); k2[j] = kv * __expf(blast[j] - bb);
                }
                *(LAS u32x4*)(lds + OFF_Q1 + t * QS + kc * 2) = pack8(q1);
                *(LAS u32x4*)(lds + OFF_Q2 + t * QS + kc * 2) = pack8(q2);
                *(LAS u32x4*)(lds + OFF_KX + t * QS + kc * 2) = pack8(kx);
                *(LAS u32x4*)(lds + OFF_K2 + t * K2S + kc * 2) = pack8(k2);
            }
            if (tq == 0) {
#pragma unroll
                for (int j = 0; j < 8; ++j) vec[kc + j] = __expf(blast[j]); }
        }
        *(LAS u32x4*)(lds + OFF_V + tv * VS + dc * 2) = rv;
        if (c > 0) {
            *(u32x4*)(gv + (unsigned)((row0 + t0 - 64 + tv) * ldv + dc)) = *(const LAS u32x4*)(outb + tv * 128 + dc * 2);
            if (IS_M && sl == 0 && tid < 64) { ((float*)(p.ws + WS_DEN))[(size_t)(row0 + t0 - 64 + tid) * 4 + h] = dmt[tid]; ((float*)(p.ws + WS_MT))[(size_t)(row0 + t0 - 64 + tid) * 4 + h] = vec[((c - 1) & 1) * 320 + 257 + tid]; }
        }
        if (c + 1 < nch) {
#pragma unroll
            for (int i = 0; i < 2; ++i) { const unsigned ro = (unsigned)((row0 + t0 + 64 + tq + 32 * i) * ldq + kc); rq[i] = *(const u32x4*)(gq + ro); rk[i] = *(const u32x4*)(gk + ro); }
            rv = *(const u32x4*)(gv + (unsigned)((row0 + t0 + 64 + tv) * ldv + dc));
        }
        __syncthreads();
        const int kb = lh * 16;
        constexpr int NU = (2 * NT + 3) / 4;
        f32x16 oacc[NU];
        if (wid < 4) {
            const int ti = wid >> 1, si = wid & 1;
            f32x16 sacc;
#pragma unroll
            for (int r = 0; r < 16; ++r) sacc[r] = 0.f;
            if (si <= ti) {
#pragma unroll
                for (int ks = 0; ks < 8; ++ks) { const bf16x8 a = *(const LAS bf16x8*)(lds + OFF_Q1 + (ti * 32 + l31) * QS + ks * 32 + kb), bb = *(const LAS bf16x8*)(lds + OFF_KX + (si * 32 + l31) * QS + ks * 32 + kb);
                    sacc = MFMA32(a, bb, sacc); }
            }
            const int s = si * 32 + l31; const float ws_s = IS_M ? vb[192 + s] : 1.0f;
#pragma unroll
            for (int r = 0; r < 16; ++r) { const int t = ti * 32 + crow(r, lane); float pv;
                if (IS_M) pv = (s <= t) ? sacc[r] * ws_s : 0.f; else pv = (s <= t) ? sacc[r] : 0.f;
                *(LAS bf16_t*)(lds + OFF_P + t * PS + s * 2) = f2bf(pv); }
        } else {
#pragma unroll
            for (int u = 0; u < NU; ++u) { const int tile = (wid - 4) + 4 * u;
#pragma unroll
                for (int r = 0; r < 16; ++r) oacc[u][r] = 0.f;
                if (tile < 2 * NT) { const int ti = tile & 1, j = tile >> 1;
#pragma unroll
                    for (int ks = 0; ks < 8; ++ks) { const bf16x8 a = *(const LAS bf16x8*)(lds + (IS_M ? OFF_Q1 : OFF_Q2) + (ti * 32 + l31) * QS + ks * 32 + kb), bb = *(const LAS bf16x8*)(lds + OFF_CT + (j * 32 + l31) * QS + ks * 32 + kb);
                        oacc[u] = MFMA32(a, bb, oacc[u]); }
                    if (IS_M) { const float dcy = vb[256];
#pragma unroll
                        for (int r = 0; r < 16; ++r) oacc[u][r] *= dcy; } } }
        }
        __syncthreads();
        if (wid < 4) {
            float dec[IS_M ? 1 : 16];
            if (IS_M) dec[0] = vb[256];
            else {
#pragma unroll
                for (int r = 0; r < 16; ++r) dec[r] = vec[wid * 32 + crow(r, lane)]; }
            bf16x8 a[4];
            tr_frag4(ldsb + OFF_K2 + trow * K2S + wid * 64 + tcolb, K2S, a);
#pragma unroll
            for (int j = 0; j < NT; ++j) {
                bf16x8 bv[4];
                tr_frag4(ldsb + OFF_V + trow * VS + j * 64 + tcolb, VS, bv);
#pragma unroll
                for (int r = 0; r < 16; ++r) st[j][r] *= dec[IS_M ? 0 : r];
#pragma unroll
                for (int ks = 0; ks < 4; ++ks) st[j] = MFMA32(a[ks], bv[ks], st[j]);
#pragma unroll
                for (int g = 0; g < 4; ++g) { u32x2 w; w.x = cvt_pk_bf16(st[j][4 * g], st[j][4 * g + 1]); w.y = cvt_pk_bf16(st[j][4 * g + 2], st[j][4 * g + 3]);
                    *(LAS u32x2*)(lds + OFF_CT + (j * 32 + l31) * QS + (wid * 32 + 8 * g + 4 * lh) * 2) = w; }
            }
        } else {
#pragma unroll
            for (int u = 0; u < NU; ++u) { const int tile = (wid - 4) + 4 * u;
                if (tile < 2 * NT) { const int ti = tile & 1, j = tile >> 1;
                    bf16x8 pa[4], bv[4];
#pragma unroll
                    for (int ks = 0; ks < 4; ++ks) pa[ks] = *(const LAS bf16x8*)(lds + OFF_P + (ti * 32 + l31) * PS + ks * 32 + kb);
                    tr_frag4(ldsb + OFF_V + trow * VS + j * 64 + tcolb, VS, bv);
#pragma unroll
                    for (int ks = 0; ks < 4; ++ks) oacc[u] = MFMA32(pa[ks], bv[ks], oacc[u]);
                    if (j < 2) {
#pragma unroll
                        for (int r = 0; r < 16; ++r) { const int t = ti * 32 + crow(r, lane); *(LAS bf16_t*)(outb + t * 128 + (j * 32 + l31) * 2) = f2bf(oacc[u][r]); }
                    } else if (IS_M && l31 == 0) {
#pragma unroll
                        for (int r = 0; r < 16; ++r) { const int t = ti * 32 + crow(r, lane); dmt[t] = oacc[u][r]; }
                    } } }
            if (IS_M && wid == 7 && c + 1 < nch) gate_vectors(c + 1);
        }
        __syncthreads();
    }
    const int tid2 = fresh_tid(), lane2 = tid2 & 63, l31b = lane2 & 31, wid2 = __builtin_amdgcn_readfirstlane(tid2 >> 6);
    { const int tv2 = tid2 >> 3, dc2 = (tid2 & 7) * 8;
      *(u32x4*)(gv + (unsigned)((row0 + 2048 - 64 + tv2) * ldv + dc2)) = *(const LAS u32x4*)(outb + tv2 * 128 + dc2 * 2); }
    if (IS_M && sl == 0 && tid2 < 64) { ((float*)(p.ws + WS_DEN))[(size_t)(row0 + 2048 - 64 + tid2) * 4 + h] = dmt[tid2]; ((float*)(p.ws + WS_MT))[(size_t)(row0 + 2048 - 64 + tid2) * 4 + h] = vec[((nch - 1) & 1) * 320 + 257 + tid2]; }
    if (wid2 < 4) {
        float* Cout; float* nout = nullptr; int ldc;
        if (IS_M) { Cout = p.out + O_PC + ((size_t)b * 4 + h) * 128 * 256 + sl * 64; ldc = 256; nout = p.out + O_PN + ((size_t)b * 4 + h) * 128; }
        else { Cout = p.out + O_PS + ((size_t)b * 8 + h) * 128 * 128 + sl * 64; ldc = 128; }
#pragma unroll
        for (int j = 0; j < NT; ++j)
#pragma unroll
            for (int r = 0; r < 16; ++r) { const int dk = wid2 * 32 + crow(r, lane2);
                if (j < 2) Cout[(size_t)dk * ldc + j * 32 + l31b] = st[j][r];
                else if (IS_M && sl == 0 && l31b == 0) nout[dk] = st[j][r]; }
    }
    if (IS_M && sl == 0 && tid2 == 448) p.out[O_PM + b * 4 + h] = m_run;
    __syncthreads();
}

__device__ __forceinline__ f32x4 bf4_to_f32(const u32x2 w) { return (f32x4){bflo(w.x), bfhi(w.x), bflo(w.y), bfhi(w.y)}; }
__device__ __forceinline__ void sample_mlstm(const Params& p, LAS unsigned char* lds, const int b, const int h) {
    const int tid = fresh_tid(), dg = tid & 63, kq = tid >> 6;
    LAS float* qs = (LAS float*)lds; LAS float* ks = qs + 1024; LAS float* red = ks + 1024; LAS float* rden = red + 16384; LAS float* gsm = rden + 64;
    const int row0 = NROWS_P + b * 8;
    f32x4 C[16];
    { const float* C0 = p.st_C + (((size_t)b * 4 + h) * 128 + kq * 16) * 256 + dg * 4;
#pragma unroll
      for (int i = 0; i < 16; ++i) C[i] = *(const f32x4*)(C0 + i * 256); }
    float nn[16];
#pragma unroll
    for (int i = 0; i < 16; ++i) nn[i] = (dg == 0) ? p.st_n[((size_t)b * 4 + h) * 128 + kq * 16 + i] : 0.f;
    u32x2 vv[8];
    { bf16_t* v = (bf16_t*)(p.ws + WS_U0) + (size_t)row0 * 1024 + h * 256 + dg * 4;
#pragma unroll
      for (int t = 0; t < 8; ++t) vv[t] = *(const u32x2*)(v + t * 1024); }
    { const int t = tid >> 6, c = (tid & 63) * 2;
      const unsigned wq = *(const unsigned*)((const bf16_t*)((unsigned char*)p.out + YS_Q) + (size_t)(row0 + t) * 512 + h * 128 + c);
      const unsigned wk = *(const unsigned*)((const bf16_t*)((unsigned char*)p.out + YS_K) + (size_t)(row0 + t) * 512 + h * 128 + c);
      qs[t * 128 + c] = bflo(wq) * 0.08838834764831845f; qs[t * 128 + c + 1] = bfhi(wq) * 0.08838834764831845f; ks[t * 128 + c] = bflo(wk); ks[t * 128 + c + 1] = bfhi(wk); }
    if (tid == 0) { const float* g = (const float*)(p.ws + WS_GATES) + (size_t)row0 * 8; float m = p.st_m[b * 4 + h];
        for (int t = 0; t < 8; ++t) { const float ig = g[t * 8 + h], lf = g[t * 8 + 4 + h], mn = fmaxf(lf + m, ig);
            gsm[t] = __expf(lf + m - mn); gsm[8 + t] = __expf(ig - mn); gsm[16 + t] = mn; m = mn; } }
    __syncthreads();
#pragma unroll 1
    for (int t = 0; t < 8; ++t) {
        const float fg = gsm[t], ii = gsm[8 + t]; const f32x4 v4 = bf4_to_f32(vv[t]);
        f32x4 part = (f32x4){0.f, 0.f, 0.f, 0.f}; float pden = 0.f;
#pragma unroll
        for (int i = 0; i < 16; ++i) { const float kk = ks[t * 128 + kq * 16 + i] * ii, qv = qs[t * 128 + kq * 16 + i];
            C[i] = C[i] * fg + v4 * kk; part += C[i] * qv; nn[i] = nn[i] * fg + kk; pden += qv * nn[i]; }
        *(LAS f32x4*)(red + (kq * 8 + t) * 256 + dg * 4) = part;
        if (dg == 0) rden[kq * 8 + t] = pden;
    }
    __syncthreads();
    { const int t = tid >> 6; f32x4 sum = (f32x4){0.f, 0.f, 0.f, 0.f};
#pragma unroll
      for (int q = 0; q < 8; ++q) sum += *(const LAS f32x4*)(red + (q * 8 + t) * 256 + dg * 4);
      u32x2 w; w.x = cvt_pk_bf16(sum[0], sum[1]); w.y = cvt_pk_bf16(sum[2], sum[3]);
      *(u32x2*)((bf16_t*)(p.ws + WS_U0) + (size_t)(row0 + t) * 1024 + h * 256 + dg * 4) = w; }
    if (tid < 8) { float d = 0.f;
#pragma unroll
        for (int q = 0; q < 8; ++q) d += rden[q * 8 + tid];
        ((float*)(p.ws + WS_DEN))[(size_t)(row0 + tid) * 4 + h] = d; ((float*)(p.ws + WS_MT))[(size_t)(row0 + tid) * 4 + h] = gsm[16 + tid]; }
    { float* Co = p.out + O_SC + (((size_t)b * 4 + h) * 128 + kq * 16) * 256 + dg * 4;
#pragma unroll
      for (int i = 0; i < 16; ++i) *(f32x4*)(Co + i * 256) = C[i]; }
    if (dg == 0) {
#pragma unroll
        for (int i = 0; i < 16; ++i) p.out[O_SN + ((size_t)b * 4 + h) * 128 + kq * 16 + i] = nn[i]; }
    if (tid == 0) p.out[O_SM + b * 4 + h] = gsm[23];
    __syncthreads();
}
__device__ __forceinline__ void sample_hgrn(const Params& p, LAS unsigned char* lds, const int b, const int h) {
    const int tid = fresh_tid(), dg = tid & 31, kq = tid >> 5;
    LAS float* fs = (LAS float*)lds; LAS float* kks = fs + 1024; LAS float* qss = kks + 1024; LAS float* red = qss + 1024;
    const int row0 = NROWS_P + b * 8;
    f32x4 S[8];
    { const float* S0 = p.st_S + (((size_t)b * 8 + h) * 128 + kq * 8) * 128 + dg * 4;
#pragma unroll
      for (int i = 0; i < 8; ++i) S[i] = *(const f32x4*)(S0 + i * 128); }
    u32x2 vv[8];
    { const bf16_t* v = (const bf16_t*)(p.ws + WS_U0 + 5 * UB) + (size_t)row0 * 1024 + h * 128 + dg * 4;
#pragma unroll
      for (int t = 0; t < 8; ++t) vv[t] = *(const u32x2*)(v + t * 1024); }
    { const int t = tid >> 6, c = (tid & 63) * 2;
      const unsigned wf = *(const unsigned*)((const bf16_t*)(p.ws + WS_U0 + 3 * UB) + (size_t)(row0 + t) * 1024 + h * 128 + c);
      const unsigned wq = *(const unsigned*)((const bf16_t*)(p.ws + WS_U0 + 4 * UB) + (size_t)(row0 + t) * 1024 + h * 128 + c);
#pragma unroll
      for (int e = 0; e < 2; ++e) { const float fl = e ? bfhi(wf) : bflo(wf), qr = e ? bfhi(wq) : bflo(wq);
          const float p0 = p.lb_param[h * 128 + c + e], p1 = p.lb_param[1024 + h * 128 + c + e], lb = __frcp_rn(1.0f + __expf(p1 - p0)), sg = sigmoidf_(fl);
          fs[t * 128 + c + e] = lb + (1.0f - lb) * sg; kks[t * 128 + c + e] = (1.0f - lb) * (1.0f - sg); qss[t * 128 + c + e] = qr * sigmoidf_(qr); } }
    __syncthreads();
#pragma unroll 1
    for (int t = 0; t < 8; ++t) {
        const f32x4 v4 = bf4_to_f32(vv[t]); f32x4 part = (f32x4){0.f, 0.f, 0.f, 0.f};
#pragma unroll
        for (int i = 0; i < 8; ++i) { const int dk = t * 128 + kq * 8 + i; S[i] = S[i] * fs[dk] + v4 * kks[dk]; part += S[i] * qss[dk]; }
        *(LAS f32x4*)(red + (kq * 8 + t) * 128 + dg * 4) = part;
    }
    __syncthreads();
    if (tid < 256) { const int t = tid >> 5; f32x4 sum = (f32x4){0.f, 0.f, 0.f, 0.f};
#pragma unroll
      for (int q = 0; q < 16; ++q) sum += *(const LAS f32x4*)(red + (q * 8 + t) * 128 + dg * 4);
      u32x2 w; w.x = cvt_pk_bf16(sum[0], sum[1]); w.y = cvt_pk_bf16(sum[2], sum[3]);
      *(u32x2*)((bf16_t*)(p.ws + WS_U0 + 5 * UB) + (size_t)(row0 + t) * 1024 + h * 128 + dg * 4) = w; }
    { float* So = p.out + O_SS + (((size_t)b * 8 + h) * 128 + kq * 8) * 128 + dg * 4;
#pragma unroll
      for (int i = 0; i < 8; ++i) *(f32x4*)(So + i * 128) = S[i]; }
    __syncthreads();
}

__device__ __forceinline__ void phase_scan(const Params& p, LAS unsigned char* lds) {
    for (int it = blockIdx.x; it < 256; it += gridDim.x) {
        if (it < 128) scan_item<3, true>(p, lds, it >> 4, (it >> 2) & 3, it & 3);
        else { const int i = it - 128; scan_item<2, false>(p, lds, i >> 4, (i >> 1) & 7, i & 1); }
    }
    for (int it = blockIdx.x; it < 1536; it += gridDim.x) {
        if (it < 512) sample_mlstm(p, lds, it >> 2, it & 3);
        else { const int i = it - 512; sample_hgrn(p, lds, i >> 3, i & 7); }
    }
}

template <int PH> __device__ __forceinline__ void run_phase(const Params& p, LAS unsigned char* lds) {
    if constexpr (PH == 0) phase_prep(p, lds);
    if constexpr (PH == 1) {
        pg8::TileOrder S; S.init(NROWS, 7168, 1024, 1024, gridDim.x, blockIdx.x, (unsigned char*)p.out + YS_XN, (unsigned char*)p.out + YS_WIN);
        pg8::EpiProj E{p.ws, p.lb_param};
        pg8::gemm_phase(lds, 1024, 1024, S, E);
    }
    if constexpr (PH == 2) phase_conv(p);
    if constexpr (PH == 3) {
        { pg8::QkvOrder<0> S{(int)gridDim.x, (int)blockIdx.x, (const char*)p.out + YS_XC, (const char*)p.ws + WS_WQK};
          pg8::EpiQkv<0> E{(bf16_t*)((unsigned char*)p.out + YS_Q)};
          pg8::gemm_phase(lds, 256, 1024, S, E); }
        { pg8::QkvOrder<1> S{(int)gridDim.x, (int)blockIdx.x, (const char*)p.ws + WS_U0, (const char*)p.ws + WS_WV};
          pg8::EpiQkv<1> E{(bf16_t*)(p.ws + WS_U0)};
          pg8::gemm_phase(lds, 256, 1024, S, E); }
    }
    if constexpr (PH == 4) phase_gates(p, lds);
    if constexpr (PH == 5) phase_scan(p, lds);
    if constexpr (PH == 6) phase_post(p);
    if constexpr (PH == 7) {
        pg8::TileOrder S; S.init(NROWS, 1024, 2048, 2048, gridDim.x, blockIdx.x, p.ws + WS_U0 + 3 * UB, p.ws + WS_WOUT);
        pg8::EpiOut E{p.out + O_Y, p.x_prompt, p.x_sample};
        pg8::gemm_phase(lds, 2048, 2048, S, E);
    }
    if constexpr (PH == 8) phase_final(p);
}

#define XB_XCNT(j)  (64 * (j))
#define XB_XSUB(j)  (1024 + 64 * (j))
#define XB_XGEN(j)  (2048 + 64 * (j))
#define XB_TOP      3072
#define XB_TOPGEN   3136
#define XB_WORDS    3200
__device__ __forceinline__ unsigned xb_ld(unsigned* p) { return __hip_atomic_load(p, __ATOMIC_RELAXED, __HIP_MEMORY_SCOPE_AGENT); }
__device__ __forceinline__ unsigned xb_add(unsigned* p, unsigned v) { return __hip_atomic_fetch_add(p, v, __ATOMIC_RELAXED, __HIP_MEMORY_SCOPE_AGENT); }
__device__ __forceinline__ unsigned xb_xcc_id() { return (unsigned)__builtin_amdgcn_s_getreg((3 << 11) | 20) & 0xFu; }
#define XB_SPIN(cond) do { unsigned _sp = 0; while (cond) { __builtin_amdgcn_s_sleep(1); if (++_sp > (1u << 22)) break; } } while (0)
__device__ __forceinline__ void grid_barrier(unsigned* bar, volatile LAS unsigned* st) {
    asm volatile("s_waitcnt vmcnt(0)" ::: "memory");
    __syncthreads();
    if (threadIdx.x == 0) {
        __builtin_amdgcn_s_waitcnt(0);
        const unsigned x = st[0], nloc = st[1], nx = st[2];
        const unsigned old = xb_add(&bar[XB_XSUB(x)], 1u), gen = old / nloc;
        if (old + 1u == (gen + 1u) * nloc) {
            __builtin_amdgcn_fence(__ATOMIC_RELEASE, "agent");
            asm volatile("s_waitcnt vmcnt(0)" ::: "memory");
            const unsigned og = xb_add(&bar[XB_TOP], 1u), tg = og / nx;
            if (og + 1u == (tg + 1u) * nx) xb_add(&bar[XB_TOPGEN], 1u);
            else XB_SPIN(xb_ld(&bar[XB_TOPGEN]) == tg);
            __builtin_amdgcn_fence(__ATOMIC_ACQUIRE, "agent");
            xb_add(&bar[XB_XGEN(x)], 1u);
            asm volatile("s_waitcnt vmcnt(0)" ::: "memory");
        } else {
            XB_SPIN(xb_ld(&bar[XB_XGEN(x)]) == gen);
            __builtin_amdgcn_fence(__ATOMIC_ACQUIRE, "agent");
            asm volatile("s_waitcnt vmcnt(0)" ::: "memory");
        }
    }
    __syncthreads();
}
#ifndef MK_ONE
#define MK_ONE 1
#endif
#if MK_ONE
__global__ void __launch_bounds__(512, 2) fwd_megakernel(Params p) {
    extern __shared__ __attribute__((aligned(16))) unsigned char smem[];
    LAS unsigned char* lds = (LAS unsigned char*)smem;
    cg::grid_group grid = cg::this_grid();
    unsigned* bar = (unsigned*)(p.ws + WS_END);
    volatile LAS unsigned* st = (volatile LAS unsigned*)(lds + LDS_BYTES - 16);
    if (threadIdx.x == 0) { const unsigned x = xb_xcc_id(); st[0] = x; (void)xb_add(&bar[XB_XCNT(x)], 1u); }
    run_phase<0>(p, lds); grid.sync();
    if (threadIdx.x == 0) { unsigned cnt = 0, mine = 1;
        for (unsigned j = 0; j < 16; ++j) { const unsigned c = xb_ld(&bar[XB_XCNT(j)]); cnt += (c > 0u) ? 1u : 0u; if (j == st[0]) mine = c; }
        st[1] = mine > 0u ? mine : 1u; st[2] = cnt > 0u ? cnt : 1u; }
    run_phase<1>(p, lds); grid_barrier(bar, st);
    run_phase<2>(p, lds); grid_barrier(bar, st);
    run_phase<3>(p, lds); grid_barrier(bar, st);
    run_phase<4>(p, lds); grid_barrier(bar, st);
    run_phase<5>(p, lds); grid_barrier(bar, st);
    run_phase<6>(p, lds); grid_barrier(bar, st);
    run_phase<7>(p, lds); grid_barrier(bar, st);
    run_phase<8>(p, lds);
}
#else
template <int PH> __global__ void __launch_bounds__(512, 2) phase_kernel(Params p) {
    extern __shared__ __attribute__((aligned(16))) unsigned char smem[];
    run_phase<PH>(p, (LAS unsigned char*)smem);
}
template <int PH> static void launch_phase(const Params& p, int grid, hipStream_t stream) {
    static bool attr = false;
    if (!attr) { (void)hipFuncSetAttribute((const void*)phase_kernel<PH>, hipFuncAttributeMaxDynamicSharedMemorySize, LDS_BYTES); attr = true; }
    hipLaunchKernelGGL(phase_kernel<PH>, dim3(grid), dim3(512), LDS_BYTES, stream, p);
}
#endif

extern "C" void kernel_launch(void* const* d_in, const int* in_sizes, int n_in, void* d_out, int out_size, void* d_ws, size_t ws_size, hipStream_t stream) {
    static int grid_blocks = 0;
    if (grid_blocks == 0) {
        if (n_in != 22 || ws_size < WS_END + 12800) { fprintf(stderr, "kernel_launch: unexpected n_in %d / ws_size %zu\n", n_in, ws_size); grid_blocks = -1; return; }
        int dev = 0, cus = 0;
        (void)hipGetDevice(&dev);
        (void)hipDeviceGetAttribute(&cus, hipDeviceAttributeMultiprocessorCount, dev);
#if MK_ONE
        int per_cu = 0;
        if (hipFuncSetAttribute((const void*)fwd_megakernel, hipFuncAttributeMaxDynamicSharedMemorySize, LDS_BYTES) != hipSuccess) { fprintf(stderr, "kernel_launch: hipFuncSetAttribute failed\n"); grid_blocks = -1; return; }
        (void)hipOccupancyMaxActiveBlocksPerMultiprocessor(&per_cu, (const void*)fwd_megakernel, 512, LDS_BYTES);
        if (per_cu < 1) per_cu = 1;
        grid_blocks = cus * per_cu;
#else
        grid_blocks = cus;
#endif
    }
    if (grid_blocks < 0) return;
    Params p{};
    const float** f = (const float**)&p;
    for (int i = 0; i < 22; ++i) f[i] = (const float*)d_in[i];
    p.out = (float*)d_out; p.ws = (unsigned char*)d_ws;
#if MK_ONE
    (void)hipMemsetAsync((unsigned char*)d_ws + WS_END, 0, 12800, stream);
    void* args[] = {&p};
    hipError_t e = hipLaunchCooperativeKernel((const void*)fwd_megakernel, dim3(grid_blocks), dim3(512), args, LDS_BYTES, stream);
    if (e != hipSuccess) fprintf(stderr, "cooperative launch failed: %s (grid %d)\n", hipGetErrorString(e), grid_blocks);
#else
    launch_phase<0>(p, grid_blocks, stream); launch_phase<1>(p, grid_blocks, stream); launch_phase<2>(p, grid_blocks, stream);
    launch_phase<3>(p, grid_blocks, stream); launch_phase<4>(p, grid_blocks, stream); launch_phase<5>(p, grid_blocks, stream);
    launch_phase<6>(p, grid_blocks, stream); launch_phase<7>(p, grid_blocks, stream); launch_phase<8>(p, grid_blocks, stream);
#endif
}
```

```cpp
#include <hip/hip_runtime.h>
#include <hip/hip_cooperative_groups.h>
#include <cstdio>
namespace cg = cooperative_groups;

typedef unsigned short bf16_t;
typedef short bf16x8 __attribute__((ext_vector_type(8)));
typedef float f32x4 __attribute__((ext_vector_type(4)));
typedef float f32x16 __attribute__((ext_vector_type(16)));
typedef unsigned u32x4 __attribute__((ext_vector_type(4)));
typedef unsigned u32x2 __attribute__((ext_vector_type(2)));
#define LAS __attribute__((address_space(3)))

constexpr int NROWS_P = 16384, NROWS = 17408, DM = 1024;
constexpr size_t UB = (size_t)NROWS * 1024 * 2;
constexpr size_t WS_U0 = 0;
constexpr size_t WS_WOUT = 7 * UB;
constexpr size_t WS_WQK = WS_WOUT + 4194304;
constexpr size_t WS_WV = WS_WQK + 524288;
constexpr size_t WS_GATES = WS_WV + 524288;
constexpr size_t WS_DEN = WS_GATES + (size_t)NROWS * 32;
constexpr size_t WS_MT = WS_DEN + (size_t)NROWS * 16;
constexpr size_t WS_END = WS_MT + (size_t)NROWS * 16;
constexpr size_t YS_XN = 0, YS_WIN = UB, YS_XC = 0, YS_Q = UB, YS_K = UB + UB / 2;
constexpr size_t O_Y = 0, O_PCONV = 17825792, O_PC = 17850368, O_PN = 18898944, O_PM = 18903040, O_PS = 18903072,
                 O_SCONV = 19951648, O_SC = 20344864, O_SN = 37122080, O_SM = 37187616, O_SS = 37188128;

constexpr int LDS_BYTES = 158224;

struct Params {
    const float* x_prompt; const float* x_sample; const float* st_conv; const float* st_C; const float* st_n; const float* st_m; const float* st_S;
    const float* g_norm; const float* w_in; const float* conv_w; const float* conv_b; const float* w_q; const float* w_k; const float* w_v;
    const float* w_gate; const float* b_gate; const float* m_ln; const float* m_skip; const float* lb_param; const float* h_norm; const float* w_out; const float* g_final;
    float* out; unsigned char* ws;
};

typedef __bf16 bf16v2 __attribute__((ext_vector_type(2)));
typedef float f32x2 __attribute__((ext_vector_type(2)));
__device__ __forceinline__ unsigned cvt_pk_bf16(float lo, float hi) { const f32x2 v = {lo, hi}; const bf16v2 r = __builtin_convertvector(v, bf16v2); return __builtin_bit_cast(unsigned, r); }
__device__ __forceinline__ bf16_t f2bf(float f) { return (bf16_t)(cvt_pk_bf16(f, 0.f) & 0xffffu); }
__device__ __forceinline__ float bf2f(bf16_t v) { return __uint_as_float(((unsigned)v) << 16); }
__device__ __forceinline__ float bflo(unsigned w) { return __uint_as_float(w << 16); }
__device__ __forceinline__ float bfhi(unsigned w) { return __uint_as_float(w & 0xffff0000u); }
__device__ __forceinline__ int fresh_tid() { int t = threadIdx.x; asm volatile("" : "+v"(t)); return t; }
__device__ __forceinline__ float sigmoidf_(float x) { return __frcp_rn(1.0f + __expf(-x)); }
__device__ __forceinline__ void unpack8(const u32x4 v, float* f) { f[0] = bflo(v.x); f[1] = bfhi(v.x); f[2] = bflo(v.y); f[3] = bfhi(v.y); f[4] = bflo(v.z); f[5] = bfhi(v.z); f[6] = bflo(v.w); f[7] = bfhi(v.w); }
__device__ __forceinline__ u32x4 pack8(const float* f) { u32x4 w; w.x = cvt_pk_bf16(f[0], f[1]); w.y = cvt_pk_bf16(f[2], f[3]); w.z = cvt_pk_bf16(f[4], f[5]); w.w = cvt_pk_bf16(f[6], f[7]); return w; }

namespace pg8 {
constexpr int BM = 256, BK = 64, HALF = 128, HTB = HALF * BK * 2, STAGE_BYTES = 8 * HTB, NXCD = 8, WGM = 8;
__host__ __device__ __forceinline__ int lds_byte(int r, int c) { const int st = (r >> 4) * 2 + (c >> 5), rr = r & 15, cc = c & 31, ob = rr * 64 + cc * 2; return st * 1024 + (ob ^ (((ob >> 9) & 1) << 5)); }
__host__ __device__ __forceinline__ void stage_rc(int b, int& R, int& C) { const int st = b / 1024, sb = b % 1024, swz = sb ^ (((sb >> 9) & 1) << 5); R = (st >> 1) * 16 + swz / 64; C = (st & 1) * 32 + (swz % 64) / 2; }
__host__ __device__ __forceinline__ int perm32(int rho) { const int n = rho >> 4, i = rho & 15; return 8 * (i >> 2) + 4 * n + (i & 3); }

struct Unit { int pm, pn; const char* a; const char* b; };

template <class Epi, class Sched>
__device__ __forceinline__ void gemm_phase(LAS unsigned char* lds, const int K, const int lda, const Sched& S, const Epi& E, const int ldb_ = 0) {
    const int tid = fresh_tid(), wid = __builtin_amdgcn_readfirstlane(tid >> 6), lane = tid & 63, wr = wid >> 2, wc = wid & 3, fr = lane & 15, fq = lane >> 4;
    const int nt = K / BK;
    unsigned voffA[2], voffB[2];
#pragma unroll
    for (int i = 0; i < 2; ++i) { int R, C; stage_rc(tid * 16 + i * 8192, R, C); const int Rb = Epi::PERM ? ((R & ~31) + perm32(R & 31)) : R;
        voffA[i] = (unsigned)(R * lda + C) * 2u; voffB[i] = (unsigned)(Rb * (ldb_ ? ldb_ : K) + C) * 2u; }
    const size_t kstep = (size_t)(BK * 2);
    const size_t hstepA = (size_t)HALF * lda * 2, hstepB = (size_t)HALF * (ldb_ ? ldb_ : K) * 2;
    const unsigned ldsw = (unsigned)wid * 1024u;
    const int aoff = lds_byte(wr * 64 + fr, fq * 8), boff = lds_byte(wc * 32 + fr, fq * 8);
#define PG8_SA(b, h) (((b) * 2 + (h)) * HTB)
#define PG8_SB(b, h) ((4 + (b) * 2 + (h)) * HTB)
#define PG8_STAGE(bufoff, gbase, voff) do { _Pragma("unroll") for (int _i = 0; _i < 2; ++_i) \
        __builtin_amdgcn_global_load_lds((const unsigned*)((const char*)(gbase) + (voff)[_i]), (LAS unsigned*)(lds + (bufoff) + ldsw + _i * 8192), 16, 0, 0); } while (0)
#define PG8_LDA(dst, b, h) do { _Pragma("unroll") for (int m = 0; m < 4; ++m) _Pragma("unroll") for (int k = 0; k < 2; ++k) dst[m][k] = *(const LAS bf16x8*)(lds + PG8_SA(b, h) + aoff + m * 2048 + k * 1024); } while (0)
#define PG8_LDB(dst, b, h) do { _Pragma("unroll") for (int n = 0; n < 2; ++n) _Pragma("unroll") for (int k = 0; k < 2; ++k) dst[n][k] = *(const LAS bf16x8*)(lds + PG8_SB(b, h) + boff + n * 2048 + k * 1024); } while (0)
#define PG8_MMA(ai, bj, At, Bt) do { __builtin_amdgcn_s_setprio(1); _Pragma("unroll") for (int m = 0; m < 4; ++m) _Pragma("unroll") for (int n = 0; n < 2; ++n) _Pragma("unroll") for (int k = 0; k < 2; ++k) \
        acc[ai][bj][m][n] = __builtin_amdgcn_mfma_f32_16x16x32_bf16(Bt[n][k], At[m][k], acc[ai][bj][m][n], 0, 0, 0); __builtin_amdgcn_s_setprio(0); } while (0)
#define PG8_WAIT_V(n) asm volatile("s_waitcnt vmcnt(" #n ")" ::: "memory")
#define PG8_WAIT_L(n) asm volatile("s_waitcnt lgkmcnt(" #n ")" ::: "memory")
#define PG8_BAR __builtin_amdgcn_s_barrier()
#define PG8_SCHED __builtin_amdgcn_sched_barrier(0)
    Unit cur, nxt; int ui = 0;
    if (!S.next(0, cur)) return;
    f32x4 acc[2][2][4][2];
#pragma unroll
    for (int a = 0; a < 2; ++a)
#pragma unroll
        for (int b = 0; b < 2; ++b)
#pragma unroll
            for (int m = 0; m < 4; ++m)
#pragma unroll
                for (int n = 0; n < 2; ++n) acc[a][b][m][n] = (f32x4){0.f, 0.f, 0.f, 0.f};
    bf16x8 At[4][2], B0[2][2], B1[2][2];
    const char* cA = cur.a; const char* cB = cur.b;
    PG8_STAGE(PG8_SB(0, 0), cB, voffB); PG8_STAGE(PG8_SB(0, 1), cB + hstepB, voffB); PG8_STAGE(PG8_SA(0, 0), cA, voffA); PG8_STAGE(PG8_SA(0, 1), cA + hstepA, voffA);
    if (wr == 1) PG8_BAR;
    PG8_WAIT_V(2); PG8_BAR;
    PG8_STAGE(PG8_SB(1, 0), cB + kstep, voffB); PG8_STAGE(PG8_SA(1, 0), cA + kstep, voffA); PG8_STAGE(PG8_SB(1, 1), cB + hstepB + kstep, voffB);
    PG8_WAIT_V(6); PG8_BAR;
    for (;;) {
        const bool has_next = S.next(ui + 1, nxt);
        const char* nA = has_next ? nxt.a : cA; const char* nB = has_next ? nxt.b : cB;
        for (int t = 0; t < nt; t += 2) {
            const bool last = (t == nt - 2);
            const char* a1 = cA + (size_t)(t + 1) * kstep;
            const char* a2 = last ? nA : cA + (size_t)(t + 2) * kstep; const char* b2 = last ? nB : cB + (size_t)(t + 2) * kstep;
            const char* a3 = a2 + kstep; const char* b3 = b2 + kstep;
            PG8_LDB(B0, 0, 0); PG8_LDB(B1, 0, 1); PG8_SCHED; PG8_LDA(At, 0, 0); PG8_STAGE(PG8_SA(1, 1), a1 + hstepA, voffA);
            PG8_WAIT_V(8); PG8_WAIT_L(0); PG8_BAR; PG8_MMA(0, 0, At, B0); PG8_MMA(0, 1, At, B1); PG8_BAR; PG8_SCHED;
            PG8_LDA(At, 0, 1); PG8_STAGE(PG8_SB(0, 0), b2, voffB); PG8_STAGE(PG8_SB(0, 1), b2 + hstepB, voffB); PG8_STAGE(PG8_SA(0, 0), a2, voffA);
            PG8_WAIT_V(8); PG8_WAIT_L(0); PG8_BAR; PG8_MMA(1, 0, At, B0); PG8_MMA(1, 1, At, B1); PG8_BAR; PG8_SCHED;
            PG8_LDB(B0, 1, 0); PG8_LDB(B1, 1, 1); PG8_SCHED; PG8_LDA(At, 1, 0); PG8_STAGE(PG8_SA(0, 1), a2 + hstepA, voffA);
            PG8_WAIT_V(8); PG8_WAIT_L(0); PG8_BAR; PG8_MMA(0, 0, At, B0); PG8_MMA(0, 1, At, B1); PG8_BAR; PG8_SCHED;
            PG8_LDA(At, 1, 1); PG8_STAGE(PG8_SB(1, 0), b3, voffB); PG8_STAGE(PG8_SB(1, 1), b3 + hstepB, voffB); PG8_STAGE(PG8_SA(1, 0), a3, voffA);
            PG8_WAIT_V(8); PG8_WAIT_L(0); PG8_BAR; PG8_MMA(1, 0, At, B0); PG8_MMA(1, 1, At, B1); PG8_BAR; PG8_SCHED;
        }
        E(acc, cur, wr, wc, fr, fq);
        if (!has_next) break;
#pragma unroll
        for (int a = 0; a < 2; ++a)
#pragma unroll
            for (int b = 0; b < 2; ++b)
#pragma unroll
                for (int m = 0; m < 4; ++m)
#pragma unroll
                    for (int n = 0; n < 2; ++n) acc[a][b][m][n] = (f32x4){0.f, 0.f, 0.f, 0.f};
        cur = nxt; cA = nA; cB = nB; ++ui;
    }
    PG8_WAIT_V(0);
    if (wr == 0) PG8_BAR;
    PG8_BAR;
#undef PG8_SA
#undef PG8_SB
#undef PG8_STAGE
#undef PG8_LDA
#undef PG8_LDB
#undef PG8_MMA
#undef PG8_WAIT_V
#undef PG8_WAIT_L
#undef PG8_BAR
#undef PG8_SCHED
}

struct TileOrder {
    int nM, nN, nwg, G, c; const char* A; const char* Bt; size_t tA, tB;
    __device__ void init(int M, int N, int K, int lda, int G_, int c_, const void* A_, const void* Bt_) { nM = M / BM; nN = N / BM; nwg = nM * nN; G = G_; c = c_; A = (const char*)A_; Bt = (const char*)Bt_; tA = (size_t)BM * lda * 2; tB = (size_t)BM * K * 2; }
    __device__ bool next(int i, Unit& u) const {
        const long L = (long)i * G + c; if (L >= nwg) return false;
        int wgid = (int)L; { const int q = nwg / NXCD, r = nwg % NXCD, xcd = wgid % NXCD, off = wgid / NXCD; wgid = (xcd < r ? xcd * (q + 1) : r * (q + 1) + (xcd - r) * q) + off; }
        const int nig = WGM * nN, gid = wgid / nig, fm = gid * WGM, gsz = (nM - fm) < WGM ? (nM - fm) : WGM;
        u.pm = fm + ((wgid % nig) % gsz); u.pn = (wgid % nig) / gsz; u.a = A + (size_t)u.pm * tA; u.b = Bt + (size_t)u.pn * tB; return true;
    }
};
template <int TYPE> struct QkvOrder {
    int G, c; const char* A; const char* W;
    __device__ bool next(int i, Unit& u) const {
        const int L = i * G + c; if (L >= 68 * 4) return false;
        u.pm = L >> 2; u.pn = L & 3;
        u.a = A + ((size_t)u.pm * 256 * 1024 + u.pn * 256) * 2; u.b = W + (size_t)u.pn * 256 * 256 * 2; return true;
    }
};

struct EpiProj {
    static constexpr bool PERM = true;
    unsigned char* ws; const float* lbp;
    __device__ __forceinline__ void operator()(const f32x4 (&acc)[2][2][4][2], const Unit& u, int wr, int wc, int fr, int fq) const {
        const int ub = u.pn >> 2;
        bf16_t* base = (bf16_t*)(ws + (size_t)ub * UB);
        const int row0 = u.pm * BM + wr * 64 + fr, col0 = (u.pn & 3) * 256 + wc * 32 + 8 * fq;
        const int mode = (u.pm < 64) ? (ub == 3 ? 1 : (ub == 4 ? 2 : 0)) : 0;
        float lb[2][8];
        if (mode == 1) {
#pragma unroll
            for (int bj = 0; bj < 2; ++bj)
#pragma unroll
                for (int e = 0; e < 8; ++e) { const int c = col0 + bj * HALF + e; lb[bj][e] = __frcp_rn(1.0f + __expf(lbp[1024 + c] - lbp[c])); }
        }
#pragma unroll
        for (int ai = 0; ai < 2; ++ai)
#pragma unroll
            for (int m = 0; m < 4; ++m) { bf16_t* rowp = base + (size_t)(row0 + ai * HALF + m * 16) * 1024 + col0;
#pragma unroll
                for (int bj = 0; bj < 2; ++bj) { float v[8];
#pragma unroll
                    for (int e = 0; e < 4; ++e) { v[e] = acc[ai][bj][m][0][e]; v[4 + e] = acc[ai][bj][m][1][e]; }
                    if (mode == 1) {
#pragma unroll
                        for (int e = 0; e < 8; ++e) v[e] = __logf(lb[bj][e] + (1.0f - lb[bj][e]) * sigmoidf_(v[e]));
                    } else if (mode == 2) {
#pragma unroll
                        for (int e = 0; e < 8; ++e) v[e] = v[e] * sigmoidf_(v[e]);
                    }
                    *(u32x4*)(rowp + bj * HALF) = pack8(v); } }
    }
};
template <int TYPE> struct EpiQkv {
    static constexpr bool PERM = true;
    bf16_t* o;
    __device__ __forceinline__ void operator()(const f32x4 (&acc)[2][2][4][2], const Unit& u, int wr, int wc, int fr, int fq) const {
        constexpr int ld = TYPE ? 1024 : 512; constexpr size_t bjoff = TYPE ? 128 : (UB / 4);
        bf16_t* base = o + u.pn * (TYPE ? 256 : 128) + (size_t)(u.pm * BM + wr * 64 + fr) * ld + wc * 32 + 8 * fq;
#pragma unroll
        for (int ai = 0; ai < 2; ++ai)
#pragma unroll
            for (int m = 0; m < 4; ++m) { bf16_t* rowp = base + (size_t)(ai * HALF + m * 16) * ld;
#pragma unroll
                for (int bj = 0; bj < 2; ++bj) { const f32x4 v0 = acc[ai][bj][m][0], v1 = acc[ai][bj][m][1];
                    u32x4 w; w.x = cvt_pk_bf16(v0[0], v0[1]); w.y = cvt_pk_bf16(v0[2], v0[3]); w.z = cvt_pk_bf16(v1[0], v1[1]); w.w = cvt_pk_bf16(v1[2], v1[3]);
                    *(u32x4*)(rowp + bj * bjoff) = w; } }
    }
};
struct TailOrder {
    int c; const char* A; const char* Bt;
    __device__ bool next(int i, Unit& u) const {
        if (i > 0 || c >= 64) return false;
        const int un = c >> 2, sl = c & 3; u.pm = un & 3; u.pn = (un >> 2) | (sl << 4);
        u.a = A + (size_t)u.pm * 256 * 2048 * 2 + sl * 1024; u.b = Bt + (size_t)(un >> 2) * 256 * 2048 * 2 + sl * 1024; return true;
    }
};
struct EpiPart {
    static constexpr bool PERM = false;
    float* part;
    __device__ __forceinline__ void operator()(const f32x4 (&acc)[2][2][4][2], const Unit& u, int wr, int wc, int fr, int fq) const {
        const int row0 = u.pm * BM + wr * 64 + fr, col0 = (u.pn & 15) * BM + wc * 32 + 4 * fq;
        float* o = part + (size_t)(u.pn >> 4) * 1024 * 1024;
#pragma unroll
        for (int ai = 0; ai < 2; ++ai)
#pragma unroll
            for (int m = 0; m < 4; ++m) { const size_t ro = (size_t)(row0 + ai * HALF + m * 16) * 1024 + col0;
#pragma unroll
                for (int bj = 0; bj < 2; ++bj)
#pragma unroll
                    for (int n = 0; n < 2; ++n) *(f32x4*)(o + ro + bj * HALF + n * 16) = acc[ai][bj][m][n]; }
    }
};
struct EpiOut {
    static constexpr bool PERM = false;
    float* y; const float* x;
    __device__ __forceinline__ void operator()(const f32x4 (&acc)[2][2][4][2], const Unit& u, int wr, int wc, int fr, int fq) const {
        const int row0 = u.pm * BM + wr * 64 + fr, col0 = u.pn * BM + wc * 32 + 4 * fq;
#pragma unroll
        for (int ai = 0; ai < 2; ++ai)
#pragma unroll
            for (int m = 0; m < 4; ++m) { const size_t ro = (size_t)(row0 + ai * HALF + m * 16) * 1024 + col0;
#pragma unroll
                for (int bj = 0; bj < 2; ++bj)
#pragma unroll
                    for (int n = 0; n < 2; ++n) { const f32x4 xv = *(const f32x4*)(x + ro + bj * HALF + n * 16); *(f32x4*)(y + ro + bj * HALF + n * 16) = acc[ai][bj][m][n] + xv; } }
    }
};
}

__device__ __forceinline__ float wave_sum(float v) {
#pragma unroll
    for (int o = 32; o >= 1; o >>= 1) v += __shfl_xor(v, o);
    return v;
}

__device__ __forceinline__ void tr_tile(LAS float* tile, const float* __restrict__ src, int ld_src, bf16_t* __restrict__ dst, int ld_dst, int r0, int c0) {
    const int tid = threadIdx.x;
    { const int tr = tid >> 4, tc = (tid & 15) * 4;
#pragma unroll
      for (int i = 0; i < 2; ++i) { const int r = tr + 32 * i; const f32x4 v = *(const f32x4*)(src + (size_t)(r0 + r) * ld_src + c0 + tc);
          tile[r * 65 + tc] = v[0]; tile[r * 65 + tc + 1] = v[1]; tile[r * 65 + tc + 2] = v[2]; tile[r * 65 + tc + 3] = v[3]; } }
    __syncthreads();
    { const int c = tid >> 3, rg = (tid & 7) * 8; float f[8];
#pragma unroll
      for (int j = 0; j < 8; ++j) f[j] = tile[(rg + j) * 65 + c];
      *(u32x4*)(dst + (size_t)(c0 + c) * ld_dst + r0 + rg) = pack8(f); }
    __syncthreads();
}

__device__ __forceinline__ void phase_prep(const Params& p, LAS unsigned char* lds) {
    LAS float* tile = (LAS float*)lds;
    bf16_t* winT = (bf16_t*)((unsigned char*)p.out + YS_WIN);
    bf16_t* woutT = (bf16_t*)(p.ws + WS_WOUT);
    bf16_t* wqkT = (bf16_t*)(p.ws + WS_WQK);
    bf16_t* wvT = (bf16_t*)(p.ws + WS_WV);
    bf16_t* xn = (bf16_t*)((unsigned char*)p.out + YS_XN);
    constexpr int T_WIN = 16 * 112, T_WOUT = 32 * 16, T_WQ = 32, T_WK = 32, T_WV = 64;
    constexpr int T_ALL = T_WIN + T_WOUT + T_WQ + T_WK + T_WV, XN_GROUPS = NROWS / 8;
    for (int w = blockIdx.x; w < T_ALL + XN_GROUPS; w += gridDim.x) {
        if (w < T_ALL) {
            int t = w;
            if (t < T_WIN) { tr_tile(tile, p.w_in, 7168, winT, 1024, (t & 15) * 64, (t >> 4) * 64); continue; }
            t -= T_WIN;
            if (t < T_WOUT) { tr_tile(tile, p.w_out, 1024, woutT, 2048, (t & 31) * 64, (t >> 5) * 64); continue; }
            t -= T_WOUT;
            if (t < T_WQ) { const int h = t >> 3, tt = t & 7; tr_tile(tile, p.w_q + (size_t)h * 256 * 128, 128, wqkT + (size_t)h * 65536, 256, (tt & 3) * 64, (tt >> 2) * 64); continue; }
            t -= T_WQ;
            if (t < T_WK) { const int h = t >> 3, tt = t & 7; tr_tile(tile, p.w_k + (size_t)h * 256 * 128, 128, wqkT + (size_t)h * 65536 + 128 * 256, 256, (tt & 3) * 64, (tt >> 2) * 64); continue; }
            t -= T_WK;
            { const int h = t >> 4, tt = t & 15; tr_tile(tile, p.w_v + (size_t)h * 65536, 256, wvT + (size_t)h * 65536, 256, (tt & 3) * 64, (tt >> 2) * 64); }
        } else {
            const int r = (w - T_ALL) * 8 + (threadIdx.x >> 6), lane = threadIdx.x & 63;
            const float* src = (r < NROWS_P) ? p.x_prompt + (size_t)r * 1024 : p.x_sample + (size_t)(r - NROWS_P) * 1024;
            f32x4 v[4]; float ss = 0.f;
#pragma unroll
            for (int i = 0; i < 4; ++i) { v[i] = *(const f32x4*)(src + lane * 4 + 256 * i); ss += v[i][0] * v[i][0] + v[i][1] * v[i][1] + v[i][2] * v[i][2] + v[i][3] * v[i][3]; }
            ss = wave_sum(ss);
            const float rstd = rsqrtf(ss * (1.0f / 1024.0f) + 1e-6f);
#pragma unroll
            for (int i = 0; i < 4; ++i) { const f32x4 g = *(const f32x4*)(p.g_norm + lane * 4 + 256 * i);
                u32x2 w; w.x = cvt_pk_bf16(v[i][0] * rstd * g[0], v[i][1] * rstd * g[1]); w.y = cvt_pk_bf16(v[i][2] * rstd * g[2], v[i][3] * rstd * g[3]);
                *(u32x2*)(xn + (size_t)r * 1024 + lane * 4 + 256 * i) = w; }
        }
    }
}

__device__ __forceinline__ void phase_conv(const Params& p) {
    const bf16_t* xm = (const bf16_t*)(p.ws + WS_U0);
    bf16_t* xc = (bf16_t*)((unsigned char*)p.out + YS_XC);
    const int nthreads = gridDim.x * blockDim.x;
    for (int idx = blockIdx.x * blockDim.x + fresh_tid(); idx < NROWS * 128; idx += nthreads) {
        const int r = idx >> 7, c0 = (idx & 127) * 8;
        int b, t; const bool samp = r >= NROWS_P;
        if (!samp) { b = r >> 11; t = r & 2047; } else { b = (r - NROWS_P) >> 3; t = (r - NROWS_P) & 7; }
        float accv[8];
        { const f32x4 b0 = *(const f32x4*)(p.conv_b + c0), b1 = *(const f32x4*)(p.conv_b + c0 + 4);
          accv[0] = b0[0]; accv[1] = b0[1]; accv[2] = b0[2]; accv[3] = b0[3]; accv[4] = b1[0]; accv[5] = b1[1]; accv[6] = b1[2]; accv[7] = b1[3]; }
        float cur[8];
#pragma unroll
        for (int j = 0; j < 4; ++j) {
            const int tt = t - 3 + j; float xv[8];
            if (tt >= 0) { unpack8(*(const u32x4*)(xm + (size_t)(r - 3 + j) * 1024 + c0), xv); }
            else if (samp) { const float* s = p.st_conv + ((size_t)b * 3 + (t + j)) * 1024 + c0; const f32x4 s0 = *(const f32x4*)s, s1 = *(const f32x4*)(s + 4);
                xv[0] = s0[0]; xv[1] = s0[1]; xv[2] = s0[2]; xv[3] = s0[3]; xv[4] = s1[0]; xv[5] = s1[1]; xv[6] = s1[2]; xv[7] = s1[3]; }
            else {
#pragma unroll
                for (int e = 0; e < 8; ++e) xv[e] = 0.f; }
            const f32x4 w0 = *(const f32x4*)(p.conv_w + j * 1024 + c0), w1 = *(const f32x4*)(p.conv_w + j * 1024 + c0 + 4);
            accv[0] += w0[0] * xv[0]; accv[1] += w0[1] * xv[1]; accv[2] += w0[2] * xv[2]; accv[3] += w0[3] * xv[3];
            accv[4] += w1[0] * xv[4]; accv[5] += w1[1] * xv[5]; accv[6] += w1[2] * xv[6]; accv[7] += w1[3] * xv[7];
            if (j == 3) {
#pragma unroll
                for (int e = 0; e < 8; ++e) cur[e] = xv[e]; }
        }
#pragma unroll
        for (int e = 0; e < 8; ++e) accv[e] = accv[e] * sigmoidf_(accv[e]);
        *(u32x4*)(xc + (size_t)r * 1024 + c0) = pack8(accv);
        float* cdst = nullptr;
        if (!samp) { if (t >= 2045) cdst = p.out + O_PCONV + ((size_t)b * 3 + (t - 2045)) * 1024 + c0; }
        else { if (t >= 5) cdst = p.out + O_SCONV + ((size_t)b * 3 + (t - 5)) * 1024 + c0; }
        if (cdst) { *(f32x4*)cdst = (f32x4){cur[0], cur[1], cur[2], cur[3]}; *(f32x4*)(cdst + 4) = (f32x4){cur[4], cur[5], cur[6], cur[7]}; }
    }
}

__device__ __forceinline__ void phase_gates(const Params& p, LAS unsigned char* lds) {
    LAS f32x4* wgA = (LAS f32x4*)lds;
    LAS f32x4* wgB = wgA + 2048;
    for (int i = threadIdx.x; i < 2048; i += blockDim.x) {
        const f32x4 a = *(const f32x4*)(p.w_gate + (size_t)i * 8), b = *(const f32x4*)(p.w_gate + (size_t)i * 8 + 4);
        const int slot = (i & 7) * 256 + (i >> 3); wgA[slot] = a; wgB[slot] = b; }
    __syncthreads();
    const bf16_t* q = (const bf16_t*)((unsigned char*)p.out + YS_Q);
    const bf16_t* k = (const bf16_t*)((unsigned char*)p.out + YS_K);
    const bf16_t* v = (const bf16_t*)(p.ws + WS_U0);
    float* gates = (float*)(p.ws + WS_GATES);
    const int tid = fresh_tid(), lane = tid & 63, wave = blockIdx.x * 8 + (tid >> 6), nw = gridDim.x * 8;
    for (int r = wave; r < NROWS; r += nw) {
        u32x4 d[4];
        d[0] = *(const u32x4*)(q + (size_t)r * 512 + lane * 8); d[1] = *(const u32x4*)(k + (size_t)r * 512 + lane * 8);
        d[2] = *(const u32x4*)(v + (size_t)r * 1024 + lane * 8); d[3] = *(const u32x4*)(v + (size_t)r * 1024 + 512 + lane * 8);
        f32x4 ga = (f32x4){0.f, 0.f, 0.f, 0.f}, gb = ga;
#pragma unroll 1
        for (int c = 0; c < 4; ++c) { float f[8]; unpack8(d[c], f);
#pragma unroll
            for (int j = 0; j < 8; ++j) { const int slot = j * 256 + c * 64 + lane; ga += wgA[slot] * f[j]; gb += wgB[slot] * f[j]; } }
        float g8[8] = {ga[0], ga[1], ga[2], ga[3], gb[0], gb[1], gb[2], gb[3]};
#pragma unroll
        for (int j = 0; j < 8; ++j) g8[j] = wave_sum(g8[j]);
        if (lane < 8) {
            float val = g8[0];
#pragma unroll
            for (int j = 1; j < 8; ++j) val = (lane == j) ? g8[j] : val;
            val += p.b_gate[lane];
            if (lane >= 4) val = fminf(val, 0.f) - __logf(1.0f + __expf(-fabsf(val)));
            gates[(size_t)r * 8 + lane] = val;
        }
    }
    __syncthreads();
}

__device__ __forceinline__ void phase_post(const Params& p) {
    const bf16_t* num = (const bf16_t*)(p.ws + WS_U0);
    const bf16_t* zm = (const bf16_t*)(p.ws + WS_U0 + UB);
    const bf16_t* om = (const bf16_t*)(p.ws + WS_U0 + 2 * UB);
    const bf16_t* oh = (const bf16_t*)(p.ws + WS_U0 + 5 * UB);
    const bf16_t* zh = (const bf16_t*)(p.ws + WS_U0 + 6 * UB);
    const bf16_t* xc = (const bf16_t*)((unsigned char*)p.out + YS_XC);
    bf16_t* mix = (bf16_t*)(p.ws + WS_U0 + 3 * UB);
    const float* den = (const float*)(p.ws + WS_DEN);
    const float* mt = (const float*)(p.ws + WS_MT);
    const int tid = fresh_tid(), lane = tid & 63, wave = blockIdx.x * 8 + (tid >> 6), nw = gridDim.x * 8;
    const int c0 = lane * 16;
    for (int r = wave; r < NROWS; r += nw) {
        {
            const int h = lane >> 4;
            float x[16], t[16];
            unpack8(*(const u32x4*)(num + (size_t)r * 1024 + c0), x); unpack8(*(const u32x4*)(num + (size_t)r * 1024 + c0 + 8), x + 8);
            const float dn = den[(size_t)r * 4 + h], m = mt[(size_t)r * 4 + h];
            const float inv = __frcp_rn(fmaxf(fabsf(dn), __expf(-m)));
            float s = 0.f;
#pragma unroll
            for (int j = 0; j < 16; ++j) { x[j] *= inv; s += x[j]; }
            s += __shfl_xor(s, 1); s += __shfl_xor(s, 2); s += __shfl_xor(s, 4); s += __shfl_xor(s, 8);
            const float mu = s * (1.0f / 256.0f);
            float vs = 0.f;
#pragma unroll
            for (int j = 0; j < 16; ++j) { x[j] -= mu; vs += x[j] * x[j]; }
            vs += __shfl_xor(vs, 1); vs += __shfl_xor(vs, 2); vs += __shfl_xor(vs, 4); vs += __shfl_xor(vs, 8);
            const float rstd = rsqrtf(vs * (1.0f / 256.0f) + 1e-6f);
            unpack8(*(const u32x4*)(om + (size_t)r * 1024 + c0), t); unpack8(*(const u32x4*)(om + (size_t)r * 1024 + c0 + 8), t + 8);
#pragma unroll
            for (int j = 0; j < 16; ++j) x[j] = x[j] * rstd * p.m_ln[c0 + j] * sigmoidf_(t[j]);
            unpack8(*(const u32x4*)(xc + (size_t)r * 1024 + c0), t); unpack8(*(const u32x4*)(xc + (size_t)r * 1024 + c0 + 8), t + 8);
#pragma unroll
            for (int j = 0; j < 16; ++j) x[j] += p.m_skip[c0 + j] * t[j];
            unpack8(*(const u32x4*)(zm + (size_t)r * 1024 + c0), t); unpack8(*(const u32x4*)(zm + (size_t)r * 1024 + c0 + 8), t + 8);
#pragma unroll
            for (int j = 0; j < 16; ++j) x[j] *= t[j] * sigmoidf_(t[j]);
            *(u32x4*)(mix + (size_t)r * 2048 + c0) = pack8(x); *(u32x4*)(mix + (size_t)r * 2048 + c0 + 8) = pack8(x + 8);
        }
        {
            float x[16], t[16];
            unpack8(*(const u32x4*)(oh + (size_t)r * 1024 + c0), x); unpack8(*(const u32x4*)(oh + (size_t)r * 1024 + c0 + 8), x + 8);
            float s = 0.f;
#pragma unroll
            for (int j = 0; j < 16; ++j) s += x[j] * x[j];
            s += __shfl_xor(s, 1); s += __shfl_xor(s, 2); s += __shfl_xor(s, 4);
            const float rstd = rsqrtf(s * (1.0f / 128.0f) + 1e-6f);
            unpack8(*(const u32x4*)(zh + (size_t)r * 1024 + c0), t); unpack8(*(const u32x4*)(zh + (size_t)r * 1024 + c0 + 8), t + 8);
#pragma unroll
            for (int j = 0; j < 16; ++j) x[j] = x[j] * rstd * p.h_norm[c0 + j] * t[j] * sigmoidf_(t[j]);
            *(u32x4*)(mix + (size_t)r * 2048 + 1024 + c0) = pack8(x); *(u32x4*)(mix + (size_t)r * 2048 + 1024 + c0 + 8) = pack8(x + 8);
        }
    }
}

template <bool PARTS>
__device__ __forceinline__ void phase_final(const Params& p, const int rbeg, const int rend, const int blk0, const int nblk) {
    float* y = p.out + O_Y;
    const int tid = fresh_tid(), lane = tid & 63, wave = ((int)blockIdx.x - blk0) * 8 + (tid >> 6), nw = nblk * 8;
    for (int r = rbeg + wave; r < rend; r += nw) {
        f32x4 v[4]; float ss = 0.f;
#pragma unroll
        for (int i = 0; i < 4; ++i) {
            if (PARTS) { const size_t o = (size_t)(r - NROWS_P) * 1024 + lane * 4 + 256 * i; const float* pt = (const float*)(p.ws + WS_U0);
                v[i] = *(const f32x4*)(p.x_sample + o) + *(const f32x4*)(pt + o) + *(const f32x4*)(pt + 1048576 + o) + *(const f32x4*)(pt + 2 * 1048576 + o) + *(const f32x4*)(pt + 3 * 1048576 + o); }
            else v[i] = *(const f32x4*)(y + (size_t)r * 1024 + lane * 4 + 256 * i);
            ss += v[i][0] * v[i][0] + v[i][1] * v[i][1] + v[i][2] * v[i][2] + v[i][3] * v[i][3]; }
        ss = wave_sum(ss);
        const float rstd = rsqrtf(ss * (1.0f / 1024.0f) + 1e-6f);
#pragma unroll
        for (int i = 0; i < 4; ++i) { const f32x4 g = *(const f32x4*)(p.g_final + lane * 4 + 256 * i);
            *(f32x4*)(y + (size_t)r * 1024 + lane * 4 + 256 * i) = v[i] * rstd * g; }
    }
}

constexpr int QS = 272, K2S = 320, VS = 192, PS = 144;
constexpr int OFF_Q1 = 0, OFF_Q2 = 17408, OFF_KX = 34816, OFF_K2 = 52224, OFF_V = 72704, OFF_P = 84992, OFF_CT = 94208, OFF_VEC = 120320, OFF_B = 123392, OFF_TOT = 156160;
#define MFMA32(a, b, c) __builtin_amdgcn_mfma_f32_32x32x16_bf16((a), (b), (c), 0, 0, 0)
__device__ __forceinline__ int crow(int reg, int lane) { return (reg & 3) + 8 * (reg >> 2) + 4 * (lane >> 5); }
typedef short s16x4 __attribute__((ext_vector_type(4)));
__device__ __forceinline__ bf16x8 tr_frag(unsigned a0, unsigned a1) {
    s16x4 lo, hi;
    asm volatile("ds_read_b64_tr_b16 %0, %2\n\tds_read_b64_tr_b16 %1, %3\n\ts_waitcnt lgkmcnt(0)" : "=&v"(lo), "=&v"(hi) : "v"(a0), "v"(a1) : "memory");
    return (bf16x8){lo[0], lo[1], lo[2], lo[3], hi[0], hi[1], hi[2], hi[3]};
}

__device__ __forceinline__ void tr_frag4(const unsigned a0, const int S, bf16x8 (&f)[4]) {
    s16x4 r0, r1, r2, r3, r4, r5, r6, r7;
    const unsigned a1 = a0 + 4 * S, a2 = a0 + 16 * S, a3 = a0 + 20 * S, a4 = a0 + 32 * S, a5 = a0 + 36 * S, a6 = a0 + 48 * S, a7 = a0 + 52 * S;
    asm volatile("ds_read_b64_tr_b16 %0, %8\n\tds_read_b64_tr_b16 %1, %9\n\tds_read_b64_tr_b16 %2, %10\n\tds_read_b64_tr_b16 %3, %11\n\t"
                 "ds_read_b64_tr_b16 %4, %12\n\tds_read_b64_tr_b16 %5, %13\n\tds_read_b64_tr_b16 %6, %14\n\tds_read_b64_tr_b16 %7, %15\n\ts_waitcnt lgkmcnt(0)"
                 : "=&v"(r0), "=&v"(r1), "=&v"(r2), "=&v"(r3), "=&v"(r4), "=&v"(r5), "=&v"(r6), "=&v"(r7)
                 : "v"(a0), "v"(a1), "v"(a2), "v"(a3), "v"(a4), "v"(a5), "v"(a6), "v"(a7) : "memory");
    f[0] = (bf16x8){r0[0], r0[1], r0[2], r0[3], r1[0], r1[1], r1[2], r1[3]}; f[1] = (bf16x8){r2[0], r2[1], r2[2], r2[3], r3[0], r3[1], r3[2], r3[3]};
    f[2] = (bf16x8){r4[0], r4[1], r4[2], r4[3], r5[0], r5[1], r5[2], r5[3]}; f[3] = (bf16x8){r6[0], r6[1], r6[2], r6[3], r7[0], r7[1], r7[2], r7[3]};
}

template <int NT, bool IS_M>
__device__ __forceinline__ void scan_item(const Params& p, LAS unsigned char* lds, const int b, const int h, const int sl) {
    const int tid = fresh_tid(), wid = __builtin_amdgcn_readfirstlane(tid >> 6), lane = tid & 63, l31 = lane & 31, lh = lane >> 5;
    constexpr int nch = 32; const int row0 = b * 2048;
    LAS float* vec = (LAS float*)(lds + OFF_VEC);
    const unsigned ldsb = (unsigned)(size_t)lds;
    const bf16_t* gq; const bf16_t* gk; bf16_t* gv; int ldq; constexpr int ldv = 1024;
    if (IS_M) { gq = (const bf16_t*)((unsigned char*)p.out + YS_Q) + h * 128; gk = (const bf16_t*)((unsigned char*)p.out + YS_K) + h * 128; ldq = 512;
                gv = (bf16_t*)(p.ws + WS_U0) + h * 256 + sl * 64; }
    else { gq = (const bf16_t*)(p.ws + WS_U0 + 4 * UB) + h * 128; gk = (const bf16_t*)(p.ws + WS_U0 + 3 * UB) + h * 128; ldq = 1024;
           gv = (bf16_t*)(p.ws + WS_U0 + 5 * UB) + h * 128 + sl * 64; }
    const float* gates = (const float*)(p.ws + WS_GATES);
    const int kc = (tid & 15) * 8, tq = tid >> 4;
    const int dc = (tid & 7) * 8, tv = tid >> 3;
    const int trow = 8 * lh + ((lane & 15) >> 2), tcolb = (16 * ((lane >> 4) & 1) + 4 * (lane & 3)) * 2;
    if (!IS_M) { if (tid < 128) { const float p0 = p.lb_param[h * 128 + tid], p1 = p.lb_param[1024 + h * 128 + tid]; const float lb = __frcp_rn(1.0f + __expf(p1 - p0)); vec[384 + tid] = lb; vec[512 + tid] = 1.0f - lb; } }
    f32x16 st[NT];
#pragma unroll
    for (int j = 0; j < NT; ++j)
#pragma unroll
        for (int r = 0; r < 16; ++r) st[j][r] = 0.f;
    for (int i = tid; i < NT * 32 * QS / 16; i += 512) *(LAS u32x4*)(lds + OFF_CT + i * 16) = (u32x4){0u, 0u, 0u, 0u};
    if (IS_M) {
        if (tid < 64) { unsigned one = 0x3F80u; asm volatile("" : "+v"(one));
#pragma unroll
            for (int i = 0; i < 4; ++i) *(LAS u32x4*)(lds + OFF_V + tid * VS + 128 + 16 * i) = (u32x4){(i == 0) ? one : 0u, 0u, 0u, 0u}; }
    }
    LAS unsigned char* outb = lds + (IS_M ? OFF_B : OFF_CT + 64 * QS);
    LAS float* glds = (LAS float*)(lds + OFF_B + 8192); LAS float* dmt = (LAS float*)(lds + OFF_B + 8192 + 16384);
    if (IS_M) { for (int i = tid; i < 2048; i += 512) { const size_t gr = (size_t)(row0 + i) * 8; glds[2 * i] = gates[gr + h]; glds[2 * i + 1] = gates[gr + 4 + h]; } }
    __syncthreads();
    float m_run = 0.f;
    auto gate_vectors = [&](const int c) {
        LAS float* vb = vec + (c & 1) * 320;
        const float ig = glds[2 * (c * 64 + lane)], lf = glds[2 * (c * 64 + lane) + 1];
        float bc = lf;
#pragma unroll
        for (int o = 1; o < 64; o <<= 1) { const float u = __shfl_up(bc, o); if (lane >= o) bc += u; }
        const float a = ig - bc;
        float M = fmaxf(a, m_run);
#pragma unroll
        for (int o = 1; o < 64; o <<= 1) { const float u = __shfl_up(M, o); if (lane >= o) M = fmaxf(M, u); }
        const float M63 = __shfl(M, 63), b63 = __shfl(bc, 63);
        vb[lane] = a; vb[64 + lane] = M; vb[128 + lane] = __expf(M63 - M) * 0.08838834764831845f; vb[192 + lane] = __expf(a - M63);
        if (lane == 0) vb[256] = __expf(m_run - M63);
        vb[257 + lane] = bc + M;
        m_run = b63 + M63;
    };
    if (IS_M && wid == 7) gate_vectors(0);
    u32x4 rq[2], rk[2], rv;
#pragma unroll
    for (int i = 0; i < 2; ++i) { const unsigned ro = (unsigned)((row0 + tq + 32 * i) * ldq + kc); rq[i] = *(const u32x4*)(gq + ro); rk[i] = *(const u32x4*)(gk + ro); }
    rv = *(const u32x4*)(gv + (unsigned)((row0 + tv) * ldv + dc));
    __syncthreads();

#pragma unroll 1
    for (int c = 0; c < nch; ++c) {
        const int t0 = c * 64;
        LAS float* vb = vec + (c & 1) * 320;
        if (IS_M) {
#pragma unroll
            for (int i = 0; i < 2; ++i) { const int t = tq + 32 * i; float f[8], g[8];
                *(LAS u32x4*)(lds + OFF_KX + t * QS + kc * 2) = rk[i];
                unpack8(rq[i], f); const float gs = vb[128 + t];
#pragma unroll
                for (int j = 0; j < 8; ++j) g[j] = f[j] * gs;
                *(LAS u32x4*)(lds + OFF_Q1 + t * QS + kc * 2) = pack8(g);
                unpack8(rk[i], f); const float ws_ = vb[192 + t];
#pragma unroll
                for (int j = 0; j < 8; ++j) g[j] = f[j] * ws_;
                *(LAS u32x4*)(lds + OFF_K2 + t * K2S + kc * 2) = pack8(g);
            }
        } else {
            LAS float* Bf = (LAS float*)(lds + OFF_B); LAS float* tot = (LAS float*)(lds + OFF_TOT);
#pragma unroll
            for (int i = 0; i < 2; ++i) { const int t = tq + 32 * i; float f[8]; unpack8(rk[i], f);
                *(LAS f32x4*)(Bf + t * 128 + kc) = (f32x4){f[0], f[1], f[2], f[3]}; *(LAS f32x4*)(Bf + t * 128 + kc + 4) = (f32x4){f[4], f[5], f[6], f[7]}; }
            __syncthreads();
            { const int k = tid & 127, seg = tid >> 7; float run = 0.f;
#pragma unroll
              for (int t = 0; t < 16; ++t) { run += Bf[(seg * 16 + t) * 128 + k]; Bf[(seg * 16 + t) * 128 + k] = run; }
              tot[seg * 128 + k] = run; }
            __syncthreads();
            float t0s[8], t1s[8], t2s[8], bmid[8], blast[8];
#pragma unroll
            for (int j = 0; j < 8; ++j) { const int k = kc + j; t0s[j] = tot[k]; t1s[j] = tot[128 + k]; t2s[j] = tot[256 + k]; bmid[j] = Bf[31 * 128 + k] + t0s[j]; blast[j] = Bf[63 * 128 + k] + t0s[j] + t1s[j] + t2s[j]; }
            const bool hiseg = (tq >= 16);
#pragma unroll
            for (int i = 0; i < 2; ++i) { const int t = tq + 32 * i; float fq[8], ff[8], q1[8], q2[8], kx[8], k2[8];
                unpack8(rq[i], fq); unpack8(rk[i], ff);
#pragma unroll
                for (int j = 0; j < 8; ++j) {
                    const float pre = (i == 0) ? (hiseg ? t0s[j] : 0.f) : (hiseg ? t0s[j] + t1s[j] + t2s[j] : t0s[j] + t1s[j]);
                    const float bb = Bf[t * 128 + kc + j] + pre;
                    const float qv = fq[j], kv = 1.0f - __expf(ff[j]);
                    q1[j] = qv * __expf(bb - bmid[j]); q2[j] = qv * __expf(bb); kx[j] = kv * __expf(bmid[j] - bb); k2[j] = kv * __expf(blast[j] - bb);
                }
                *(LAS u32x4*)(lds + OFF_Q1 + t * QS + kc * 2) = pack8(q1);
                *(LAS u32x4*)(lds + OFF_Q2 + t * QS + kc * 2) = pack8(q2);
                *(LAS u32x4*)(lds + OFF_KX + t * QS + kc * 2) = pack8(kx);
                *(LAS u32x4*)(lds + OFF_K2 + t * K2S + kc * 2) = pack8(k2);
            }
            if (tq == 0) {
#pragma unroll
                for (int j = 0; j < 8; ++j) vec[kc + j] = __expf(blast[j]); }
        }
        *(LAS u32x4*)(lds + OFF_V + tv * VS + dc * 2) = rv;
        if (c > 0) {
            *(u32x4*)(gv + (unsigned)((row0 + t0 - 64 + tv) * ldv + dc)) = *(const LAS u32x4*)(outb + tv * 128 + dc * 2);
            if (IS_M && sl == 0 && tid < 64) { ((float*)(p.ws + WS_DEN))[(size_t)(row0 + t0 - 64 + tid) * 4 + h] = dmt[tid]; ((float*)(p.ws + WS_MT))[(size_t)(row0 + t0 - 64 + tid) * 4 + h] = vec[((c - 1) & 1) * 320 + 257 + tid]; }
        }
        if (c + 1 < nch) {
#pragma unroll
            for (int i = 0; i < 2; ++i) { const unsigned ro = (unsigned)((row0 + t0 + 64 + tq + 32 * i) * ldq + kc); rq[i] = *(const u32x4*)(gq + ro); rk[i] = *(const u32x4*)(gk + ro); }
            rv = *(const u32x4*)(gv + (unsigned)((row0 + t0 + 64 + tv) * ldv + dc));
        }
        __syncthreads();
        const int kb = lh * 16;
        constexpr int NU = (2 * NT + 3) / 4;
        f32x16 oacc[NU];
        if (wid < 4) {
            const int ti = wid >> 1, si = wid & 1;
            f32x16 sacc;
#pragma unroll
            for (int r = 0; r < 16; ++r) sacc[r] = 0.f;
            if (si <= ti) {
#pragma unroll
                for (int ks = 0; ks < 8; ++ks) { const bf16x8 a = *(const LAS bf16x8*)(lds + OFF_Q1 + (ti * 32 + l31) * QS + ks * 32 + kb), bb = *(const LAS bf16x8*)(lds + OFF_KX + (si * 32 + l31) * QS + ks * 32 + kb);
                    sacc = MFMA32(a, bb, sacc); }
            }
            const int s = si * 32 + l31; const float ws_s = IS_M ? vb[192 + s] : 1.0f;
#pragma unroll
            for (int r = 0; r < 16; ++r) { const int t = ti * 32 + crow(r, lane); float pv;
                if (IS_M) pv = (s <= t) ? sacc[r] * ws_s : 0.f; else pv = (s <= t) ? sacc[r] : 0.f;
                *(LAS bf16_t*)(lds + OFF_P + t * PS + s * 2) = f2bf(pv); }
        } else {
#pragma unroll
            for (int u = 0; u < NU; ++u) { const int tile = (wid - 4) + 4 * u;
#pragma unroll
                for (int r = 0; r < 16; ++r) oacc[u][r] = 0.f;
                if (tile < 2 * NT) { const int ti = tile & 1, j = tile >> 1;
#pragma unroll
                    for (int ks = 0; ks < 8; ++ks) { const bf16x8 a = *(const LAS bf16x8*)(lds + (IS_M ? OFF_Q1 : OFF_Q2) + (ti * 32 + l31) * QS + ks * 32 + kb), bb = *(const LAS bf16x8*)(lds + OFF_CT + (j * 32 + l31) * QS + ks * 32 + kb);
                        oacc[u] = MFMA32(a, bb, oacc[u]); }
                    if (IS_M) { const float dcy = vb[256];
#pragma unroll
                        for (int r = 0; r < 16; ++r) oacc[u][r] *= dcy; } } }
        }
        __syncthreads();
        if (wid < 4) {
            float dec[IS_M ? 1 : 16];
            if (IS_M) dec[0] = vb[256];
            else {
#pragma unroll
                for (int r = 0; r < 16; ++r) dec[r] = vec[wid * 32 + crow(r, lane)]; }
            bf16x8 a[4];
            tr_frag4(ldsb + OFF_K2 + trow * K2S + wid * 64 + tcolb, K2S, a);
#pragma unroll
            for (int j = 0; j < NT; ++j) {
                bf16x8 bv[4];
                tr_frag4(ldsb + OFF_V + trow * VS + j * 64 + tcolb, VS, bv);
#pragma unroll
                for (int r = 0; r < 16; ++r) st[j][r] *= dec[IS_M ? 0 : r];
#pragma unroll
                for (int ks = 0; ks < 4; ++ks) st[j] = MFMA32(a[ks], bv[ks], st[j]);
#pragma unroll
                for (int g = 0; g < 4; ++g) { u32x2 w; w.x = cvt_pk_bf16(st[j][4 * g], st[j][4 * g + 1]); w.y = cvt_pk_bf16(st[j][4 * g + 2], st[j][4 * g + 3]);
                    *(LAS u32x2*)(lds + OFF_CT + (j * 32 + l31) * QS + (wid * 32 + 8 * g + 4 * lh) * 2) = w; }
            }
        } else {
#pragma unroll
            for (int u = 0; u < NU; ++u) { const int tile = (wid - 4) + 4 * u;
                if (tile < 2 * NT) { const int ti = tile & 1, j = tile >> 1;
                    bf16x8 pa[4], bv[4];
#pragma unroll
                    for (int ks = 0; ks < 4; ++ks) pa[ks] = *(const LAS bf16x8*)(lds + OFF_P + (ti * 32 + l31) * PS + ks * 32 + kb);
                    tr_frag4(ldsb + OFF_V + trow * VS + j * 64 + tcolb, VS, bv);
#pragma unroll
                    for (int ks = 0; ks < 4; ++ks) oacc[u] = MFMA32(pa[ks], bv[ks], oacc[u]);
                    if (j < 2) {
#pragma unroll
                        for (int r = 0; r < 16; ++r) { const int t = ti * 32 + crow(r, lane); *(LAS bf16_t*)(outb + t * 128 + (j * 32 + l31) * 2) = f2bf(oacc[u][r]); }
                    } else if (IS_M && l31 == 0) {
#pragma unroll
                        for (int r = 0; r < 16; ++r) { const int t = ti * 32 + crow(r, lane); dmt[t] = oacc[u][r]; }
                    } } }
            if (IS_M && wid == 7 && c + 1 < nch) gate_vectors(c + 1);
        }
        __syncthreads();
    }
    const int tid2 = fresh_tid(), lane2 = tid2 & 63, l31b = lane2 & 31, wid2 = __builtin_amdgcn_readfirstlane(tid2 >> 6);
    { const int tv2 = tid2 >> 3, dc2 = (tid2 & 7) * 8;
      *(u32x4*)(gv + (unsigned)((row0 + 2048 - 64 + tv2) * ldv + dc2)) = *(const LAS u32x4*)(outb + tv2 * 128 + dc2 * 2); }
    if (IS_M && sl == 0 && tid2 < 64) { ((float*)(p.ws + WS_DEN))[(size_t)(row0 + 2048 - 64 + tid2) * 4 + h] = dmt[tid2]; ((float*)(p.ws + WS_MT))[(size_t)(row0 + 2048 - 64 + tid2) * 4 + h] = vec[((nch - 1) & 1) * 320 + 257 + tid2]; }
    if (wid2 < 4) {
        float* Cout; float* nout = nullptr; int ldc;
        if (IS_M) { Cout = p.out + O_PC + ((size_t)b * 4 + h) * 128 * 256 + sl * 64; ldc = 256; nout = p.out + O_PN + ((size_t)b * 4 + h) * 128; }
        else { Cout = p.out + O_PS + ((size_t)b * 8 + h) * 128 * 128 + sl * 64; ldc = 128; }
#pragma unroll
        for (int j = 0; j < NT; ++j)
#pragma unroll
            for (int r = 0; r < 16; ++r) { const int dk = wid2 * 32 + crow(r, lane2);
                if (j < 2) Cout[(size_t)dk * ldc + j * 32 + l31b] = st[j][r];
                else if (IS_M && sl == 0 && l31b == 0) nout[dk] = st[j][r]; }
    }
    if (IS_M && sl == 0 && tid2 == 448) p.out[O_PM + b * 4 + h] = m_run;
    __syncthreads();
}

__device__ __forceinline__ f32x4 bf4_to_f32(const u32x2 w) { return (f32x4){bflo(w.x), bfhi(w.x), bflo(w.y), bfhi(w.y)}; }
__device__ __forceinline__ void sample_mlstm(const Params& p, LAS unsigned char* lds, const int b, const int h) {
    const int tid = fresh_tid(), dg = tid & 63, kq = tid >> 6;
    LAS float* qs = (LAS float*)lds; LAS float* ks = qs + 1024; LAS float* red = ks + 1024; LAS float* rden = red + 16384; LAS float* gsm = rden + 64;
    const int row0 = NROWS_P + b * 8;
    f32x4 C[16];
    { const float* C0 = p.st_C + (((size_t)b * 4 + h) * 128 + kq * 16) * 256 + dg * 4;
#pragma unroll
      for (int i = 0; i < 16; ++i) C[i] = *(const f32x4*)(C0 + i * 256); }
    float nn[16];
#pragma unroll
    for (int i = 0; i < 16; ++i) nn[i] = (dg == 0) ? p.st_n[((size_t)b * 4 + h) * 128 + kq * 16 + i] : 0.f;
    u32x2 vv[8];
    { bf16_t* v = (bf16_t*)(p.ws + WS_U0) + (size_t)row0 * 1024 + h * 256 + dg * 4;
#pragma unroll
      for (int t = 0; t < 8; ++t) vv[t] = *(const u32x2*)(v + t * 1024); }
    { const int t = tid >> 6, c = (tid & 63) * 2;
      const unsigned wq = *(const unsigned*)((const bf16_t*)((unsigned char*)p.out + YS_Q) + (size_t)(row0 + t) * 512 + h * 128 + c);
      const unsigned wk = *(const unsigned*)((const bf16_t*)((unsigned char*)p.out + YS_K) + (size_t)(row0 + t) * 512 + h * 128 + c);
      qs[t * 128 + c] = bflo(wq) * 0.08838834764831845f; qs[t * 128 + c + 1] = bfhi(wq) * 0.08838834764831845f; ks[t * 128 + c] = bflo(wk); ks[t * 128 + c + 1] = bfhi(wk); }
    if (tid == 0) { const float* g = (const float*)(p.ws + WS_GATES) + (size_t)row0 * 8; float m = p.st_m[b * 4 + h];
        for (int t = 0; t < 8; ++t) { const float ig = g[t * 8 + h], lf = g[t * 8 + 4 + h], mn = fmaxf(lf + m, ig);
            gsm[t] = __expf(lf + m - mn); gsm[8 + t] = __expf(ig - mn); gsm[16 + t] = mn; m = mn; } }
    __syncthreads();
#pragma unroll 1
    for (int t = 0; t < 8; ++t) {
        const float fg = gsm[t], ii = gsm[8 + t]; const f32x4 v4 = bf4_to_f32(vv[t]);
        f32x4 part = (f32x4){0.f, 0.f, 0.f, 0.f}; float pden = 0.f;
#pragma unroll
        for (int i = 0; i < 16; ++i) { const float kk = ks[t * 128 + kq * 16 + i] * ii, qv = qs[t * 128 + kq * 16 + i];
            C[i] = C[i] * fg + v4 * kk; part += C[i] * qv; nn[i] = nn[i] * fg + kk; pden += qv * nn[i]; }
        *(LAS f32x4*)(red + (kq * 8 + t) * 256 + dg * 4) = part;
        if (dg == 0) rden[kq * 8 + t] = pden;
    }
    __syncthreads();
    { const int t = tid >> 6; f32x4 sum = (f32x4){0.f, 0.f, 0.f, 0.f};
#pragma unroll
      for (int q = 0; q < 8; ++q) sum += *(const LAS f32x4*)(red + (q * 8 + t) * 256 + dg * 4);
      u32x2 w; w.x = cvt_pk_bf16(sum[0], sum[1]); w.y = cvt_pk_bf16(sum[2], sum[3]);
      *(u32x2*)((bf16_t*)(p.ws + WS_U0) + (size_t)(row0 + t) * 1024 + h * 256 + dg * 4) = w; }
    if (tid < 8) { float d = 0.f;
#pragma unroll
        for (int q = 0; q < 8; ++q) d += rden[q * 8 + tid];
        ((float*)(p.ws + WS_DEN))[(size_t)(row0 + tid) * 4 + h] = d; ((float*)(p.ws + WS_MT))[(size_t)(row0 + tid) * 4 + h] = gsm[16 + tid]; }
    { float* Co = p.out + O_SC + (((size_t)b * 4 + h) * 128 + kq * 16) * 256 + dg * 4;
#pragma unroll
      for (int i = 0; i < 16; ++i) *(f32x4*)(Co + i * 256) = C[i]; }
    if (dg == 0) {
#pragma unroll
        for (int i = 0; i < 16; ++i) p.out[O_SN + ((size_t)b * 4 + h) * 128 + kq * 16 + i] = nn[i]; }
    if (tid == 0) p.out[O_SM + b * 4 + h] = gsm[23];
    __syncthreads();
}
__device__ __forceinline__ void sample_hgrn(const Params& p, LAS unsigned char* lds, const int b, const int h) {
    const int tid = fresh_tid(), dg = tid & 31, kq = tid >> 5;
    LAS float* fs = (LAS float*)lds; LAS float* kks = fs + 1024; LAS float* qss = kks + 1024; LAS float* red = qss + 1024;
    const int row0 = NROWS_P + b * 8;
    f32x4 S[8];
    { const float* S0 = p.st_S + (((size_t)b * 8 + h) * 128 + kq * 8) * 128 + dg * 4;
#pragma unroll
      for (int i = 0; i < 8; ++i) S[i] = *(const f32x4*)(S0 + i * 128); }
    u32x2 vv[8];
    { const bf16_t* v = (const bf16_t*)(p.ws + WS_U0 + 5 * UB) + (size_t)row0 * 1024 + h * 128 + dg * 4;
#pragma unroll
      for (int t = 0; t < 8; ++t) vv[t] = *(const u32x2*)(v + t * 1024); }
    { const int t = tid >> 6, c = (tid & 63) * 2;
      const unsigned wf = *(const unsigned*)((const bf16_t*)(p.ws + WS_U0 + 3 * UB) + (size_t)(row0 + t) * 1024 + h * 128 + c);
      const unsigned wq = *(const unsigned*)((const bf16_t*)(p.ws + WS_U0 + 4 * UB) + (size_t)(row0 + t) * 1024 + h * 128 + c);
#pragma unroll
      for (int e = 0; e < 2; ++e) { const float fl = e ? bfhi(wf) : bflo(wf), qr = e ? bfhi(wq) : bflo(wq);
          const float p0 = p.lb_param[h * 128 + c + e], p1 = p.lb_param[1024 + h * 128 + c + e], lb = __frcp_rn(1.0f + __expf(p1 - p0)), sg = sigmoidf_(fl);
          fs[t * 128 + c + e] = lb + (1.0f - lb) * sg; kks[t * 128 + c + e] = (1.0f - lb) * (1.0f - sg); qss[t * 128 + c + e] = qr * sigmoidf_(qr); } }
    __syncthreads();
#pragma unroll 1
    for (int t = 0; t < 8; ++t) {
        const f32x4 v4 = bf4_to_f32(vv[t]); f32x4 part = (f32x4){0.f, 0.f, 0.f, 0.f};
#pragma unroll
        for (int i = 0; i < 8; ++i) { const int dk = t * 128 + kq * 8 + i; S[i] = S[i] * fs[dk] + v4 * kks[dk]; part += S[i] * qss[dk]; }
        *(LAS f32x4*)(red + (kq * 8 + t) * 128 + dg * 4) = part;
    }
    __syncthreads();
    if (tid < 256) { const int t = tid >> 5; f32x4 sum = (f32x4){0.f, 0.f, 0.f, 0.f};
#pragma unroll
      for (int q = 0; q < 16; ++q) sum += *(const LAS f32x4*)(red + (q * 8 + t) * 128 + dg * 4);
      u32x2 w; w.x = cvt_pk_bf16(sum[0], sum[1]); w.y = cvt_pk_bf16(sum[2], sum[3]);
      *(u32x2*)((bf16_t*)(p.ws + WS_U0 + 5 * UB) + (size_t)(row0 + t) * 1024 + h * 128 + dg * 4) = w; }
    { float* So = p.out + O_SS + (((size_t)b * 8 + h) * 128 + kq * 8) * 128 + dg * 4;
#pragma unroll
      for (int i = 0; i < 8; ++i) *(f32x4*)(So + i * 128) = S[i]; }
    __syncthreads();
}

__device__ __forceinline__ void phase_scan(const Params& p, LAS unsigned char* lds) {
    for (int it = blockIdx.x; it < 256; it += gridDim.x) {
        if (it < 128) scan_item<3, true>(p, lds, it >> 4, (it >> 2) & 3, it & 3);
        else { const int i = it - 128; scan_item<2, false>(p, lds, i >> 4, (i >> 1) & 7, i & 1); }
    }
    for (int it = blockIdx.x; it < 1536; it += gridDim.x) {
        if (it < 512) sample_mlstm(p, lds, it >> 2, it & 3);
        else { const int i = it - 512; sample_hgrn(p, lds, i >> 3, i & 7); }
    }
}

template <int PH> __device__ __forceinline__ void run_phase(const Params& p, LAS unsigned char* lds) {
    if constexpr (PH == 0) phase_prep(p, lds);
    if constexpr (PH == 1) {
        pg8::TileOrder S; S.init(NROWS, 7168, 1024, 1024, gridDim.x, blockIdx.x, (unsigned char*)p.out + YS_XN, (unsigned char*)p.out + YS_WIN);
        pg8::EpiProj E{p.ws, p.lb_param};
        pg8::gemm_phase(lds, 1024, 1024, S, E);
    }
    if constexpr (PH == 2) phase_conv(p);
    if constexpr (PH == 3) {
        { pg8::QkvOrder<0> S{(int)gridDim.x, (int)blockIdx.x, (const char*)p.out + YS_XC, (const char*)p.ws + WS_WQK};
          pg8::EpiQkv<0> E{(bf16_t*)((unsigned char*)p.out + YS_Q)};
          pg8::gemm_phase(lds, 256, 1024, S, E); }
        { pg8::QkvOrder<1> S{(int)gridDim.x, (int)blockIdx.x, (const char*)p.ws + WS_U0, (const char*)p.ws + WS_WV};
          pg8::EpiQkv<1> E{(bf16_t*)(p.ws + WS_U0)};
          pg8::gemm_phase(lds, 256, 1024, S, E); }
    }
    if constexpr (PH == 4) phase_gates(p, lds);
    if constexpr (PH == 5) phase_scan(p, lds);
    if constexpr (PH == 6) phase_post(p);
    if constexpr (PH == 7) {
        pg8::TileOrder S; S.init(NROWS_P, 1024, 2048, 2048, gridDim.x, blockIdx.x, p.ws + WS_U0 + 3 * UB, p.ws + WS_WOUT);
        pg8::EpiOut E{p.out + O_Y, p.x_prompt};
        pg8::gemm_phase(lds, 2048, 2048, S, E);
    }
    if constexpr (PH == 8) {
        if (blockIdx.x < 64) {
            pg8::TailOrder S{(int)blockIdx.x, (const char*)p.ws + WS_U0 + 3 * UB + (size_t)NROWS_P * 2048 * 2, (const char*)p.ws + WS_WOUT};
            pg8::EpiPart E{(float*)(p.ws + WS_U0)};
            pg8::gemm_phase(lds, 512, 2048, S, E, 2048);
        } else phase_final<false>(p, 0, NROWS_P, 64, (int)gridDim.x - 64);
    }
    if constexpr (PH == 9) phase_final<true>(p, NROWS_P, NROWS, 0, (int)gridDim.x);
}

#define XB_XCNT(j)  (64 * (j))
#define XB_XSUB(j)  (1024 + 64 * (j))
#define XB_XGEN(j)  (2048 + 64 * (j))
#define XB_TOP      3072
#define XB_TOPGEN   3136
#define XB_WORDS    3200
__device__ __forceinline__ unsigned xb_ld(unsigned* p) { return __hip_atomic_load(p, __ATOMIC_RELAXED, __HIP_MEMORY_SCOPE_AGENT); }
__device__ __forceinline__ unsigned xb_add(unsigned* p, unsigned v) { return __hip_atomic_fetch_add(p, v, __ATOMIC_RELAXED, __HIP_MEMORY_SCOPE_AGENT); }
__device__ __forceinline__ unsigned xb_xcc_id() { return (unsigned)__builtin_amdgcn_s_getreg((3 << 11) | 20) & 0xFu; }
#define XB_SPIN(cond) do { unsigned _sp = 0; while (cond) { __builtin_amdgcn_s_sleep(1); if (++_sp > (1u << 22)) break; } } while (0)
__device__ __forceinline__ void grid_barrier(unsigned* bar, volatile LAS unsigned* st) {
    asm volatile("s_waitcnt vmcnt(0)" ::: "memory");
    __syncthreads();
    if (threadIdx.x == 0) {
        __builtin_amdgcn_s_waitcnt(0);
        const unsigned x = st[0], nloc = st[1], nx = st[2];
        const unsigned old = xb_add(&bar[XB_XSUB(x)], 1u), gen = old / nloc;
        if (old + 1u == (gen + 1u) * nloc) {
            __builtin_amdgcn_fence(__ATOMIC_RELEASE, "agent");
            asm volatile("s_waitcnt vmcnt(0)" ::: "memory");
            const unsigned og = xb_add(&bar[XB_TOP], 1u), tg = og / nx;
            if (og + 1u == (tg + 1u) * nx) xb_add(&bar[XB_TOPGEN], 1u);
            else XB_SPIN(xb_ld(&bar[XB_TOPGEN]) == tg);
            __builtin_amdgcn_fence(__ATOMIC_ACQUIRE, "agent");
            xb_add(&bar[XB_XGEN(x)], 1u);
            asm volatile("s_waitcnt vmcnt(0)" ::: "memory");
        } else {
            XB_SPIN(xb_ld(&bar[XB_XGEN(x)]) == gen);
            __builtin_amdgcn_fence(__ATOMIC_ACQUIRE, "agent");
            asm volatile("s_waitcnt vmcnt(0)" ::: "memory");
        }
    }
    __syncthreads();
}
#ifndef MK_ONE
#define MK_ONE 1
#endif
#if MK_ONE
__global__ void __launch_bounds__(512, 2) fwd_megakernel(Params p) {
    extern __shared__ __attribute__((aligned(16))) unsigned char smem[];
    LAS unsigned char* lds = (LAS unsigned char*)smem;
    cg::grid_group grid = cg::this_grid();
    unsigned* bar = (unsigned*)(p.ws + WS_END);
    volatile LAS unsigned* st = (volatile LAS unsigned*)(lds + LDS_BYTES - 16);
    if (threadIdx.x == 0) { const unsigned x = xb_xcc_id(); st[0] = x; (void)xb_add(&bar[XB_XCNT(x)], 1u); }
    run_phase<0>(p, lds); grid.sync();
    if (threadIdx.x == 0) { unsigned cnt = 0, mine = 1;
        for (unsigned j = 0; j < 16; ++j) { const unsigned c = xb_ld(&bar[XB_XCNT(j)]); cnt += (c > 0u) ? 1u : 0u; if (j == st[0]) mine = c; }
        st[1] = mine > 0u ? mine : 1u; st[2] = cnt > 0u ? cnt : 1u; }
    run_phase<1>(p, lds); grid_barrier(bar, st);
    run_phase<2>(p, lds); grid_barrier(bar, st);
    run_phase<3>(p, lds); grid_barrier(bar, st);
    run_phase<4>(p, lds); grid_barrier(bar, st);
    run_phase<5>(p, lds); grid_barrier(bar, st);
    run_phase<6>(p, lds); grid_barrier(bar, st);
    run_phase<7>(p, lds); grid_barrier(bar, st);
    run_phase<8>(p, lds); grid_barrier(bar, st);
    run_phase<9>(p, lds);
}
#else
template <int PH> __global__ void __launch_bounds__(512, 2) phase_kernel(Params p) {
    extern __shared__ __attribute__((aligned(16))) unsigned char smem[];
    run_phase<PH>(p, (LAS unsigned char*)smem);
}
template <int PH> static void launch_phase(const Params& p, int grid, hipStream_t stream) {
    static bool attr = false;
    if (!attr) { (void)hipFuncSetAttribute((const void*)phase_kernel<PH>, hipFuncAttributeMaxDynamicSharedMemorySize, LDS_BYTES); attr = true; }
    hipLaunchKernelGGL(phase_kernel<PH>, dim3(grid), dim3(512), LDS_BYTES, stream, p);
}
#endif

extern "C" void kernel_launch(void* const* d_in, const int* in_sizes, int n_in, void* d_out, int out_size, void* d_ws, size_t ws_size, hipStream_t stream) {
    static int grid_blocks = 0;
    if (grid_blocks == 0) {
        if (n_in != 22 || ws_size < WS_END + 12800) { fprintf(stderr, "kernel_launch: unexpected n_in %d / ws_size %zu\n", n_in, ws_size); grid_blocks = -1; return; }
        int dev = 0, cus = 0;
        (void)hipGetDevice(&dev);
        (void)hipDeviceGetAttribute(&cus, hipDeviceAttributeMultiprocessorCount, dev);
#if MK_ONE
        int per_cu = 0;
        if (hipFuncSetAttribute((const void*)fwd_megakernel, hipFuncAttributeMaxDynamicSharedMemorySize, LDS_BYTES) != hipSuccess) { fprintf(stderr, "kernel_launch: hipFuncSetAttribute failed\n"); grid_blocks = -1; return; }
        (void)hipOccupancyMaxActiveBlocksPerMultiprocessor(&per_cu, (const void*)fwd_megakernel, 512, LDS_BYTES);
        if (per_cu < 1) per_cu = 1;
        grid_blocks = cus * per_cu;
#else
        grid_blocks = cus;
#endif
    }
    if (grid_blocks < 0) return;
    Params p{};
    const float** f = (const float**)&p;
    for (int i = 0; i < 22; ++i) f[i] = (const float*)d_in[i];
    p.out = (float*)d_out; p.ws = (unsigned char*)d_ws;
#if MK_ONE
    (void)hipMemsetAsync((unsigned char*)d_ws + WS_END, 0, 12800, stream);
    void* args[] = {&p};
    hipError_t e = hipLaunchCooperativeKernel((const void*)fwd_megakernel, dim3(grid_blocks), dim3(512), args, LDS_BYTES, stream);
    if (e != hipSuccess) fprintf(stderr, "cooperative launch failed: %s (grid %d)\n", hipGetErrorString(e), grid_blocks);
#else
    launch_phase<0>(p, grid_blocks, stream); launch_phase<1>(p, grid_blocks, stream); launch_phase<2>(p, grid_blocks, stream);
    launch_phase<3>(p, grid_blocks, stream); launch_phase<4>(p, grid_blocks, stream); launch_phase<5>(p, grid_blocks, stream);
    launch_phase<6>(p, grid_blocks, stream); launch_phase<7>(p, grid_blocks, stream); launch_phase<8>(p, grid_blocks, stream); launch_phase<9>(p, grid_blocks, stream);
#endif
}
```

```cpp
#include <hip/hip_runtime.h>
#include <hip/hip_cooperative_groups.h>
#include <cstdio>
namespace cg = cooperative_groups;

typedef unsigned short bf16_t;
typedef short bf16x8 __attribute__((ext_vector_type(8)));
typedef float f32x4 __attribute__((ext_vector_type(4)));
typedef float f32x16 __attribute__((ext_vector_type(16)));
typedef unsigned u32x4 __attribute__((ext_vector_type(4)));
typedef unsigned u32x2 __attribute__((ext_vector_type(2)));
#define LAS __attribute__((address_space(3)))

constexpr int NROWS_P = 16384, NROWS = 17408, DM = 1024;
constexpr size_t UB = (size_t)NROWS * 1024 * 2;
constexpr size_t WS_U0 = 0;
constexpr size_t WS_WOUT = 7 * UB;
constexpr size_t WS_WQK = WS_WOUT + 4194304;
constexpr size_t WS_WV = WS_WQK + 524288;
constexpr size_t WS_GATES = WS_WV + 524288;
constexpr size_t WS_DEN = WS_GATES + (size_t)NROWS * 32;
constexpr size_t WS_MT = WS_DEN + (size_t)NROWS * 16;
constexpr size_t WS_END = WS_MT + (size_t)NROWS * 16;
constexpr size_t YS_XN = 0, YS_WIN = UB, YS_XC = 0, YS_Q = UB, YS_K = UB + UB / 2;
constexpr size_t O_Y = 0, O_PCONV = 17825792, O_PC = 17850368, O_PN = 18898944, O_PM = 18903040, O_PS = 18903072,
                 O_SCONV = 19951648, O_SC = 20344864, O_SN = 37122080, O_SM = 37187616, O_SS = 37188128;

constexpr int LDS_BYTES = 158224;

struct Params {
    const float* x_prompt; const float* x_sample; const float* st_conv; const float* st_C; const float* st_n; const float* st_m; const float* st_S;
    const float* g_norm; const float* w_in; const float* conv_w; const float* conv_b; const float* w_q; const float* w_k; const float* w_v;
    const float* w_gate; const float* b_gate; const float* m_ln; const float* m_skip; const float* lb_param; const float* h_norm; const float* w_out; const float* g_final;
    float* out; unsigned char* ws;
};

typedef __bf16 bf16v2 __attribute__((ext_vector_type(2)));
typedef float f32x2 __attribute__((ext_vector_type(2)));
__device__ __forceinline__ unsigned cvt_pk_bf16(float lo, float hi) { const f32x2 v = {lo, hi}; const bf16v2 r = __builtin_convertvector(v, bf16v2); return __builtin_bit_cast(unsigned, r); }
__device__ __forceinline__ bf16_t f2bf(float f) { return (bf16_t)(cvt_pk_bf16(f, 0.f) & 0xffffu); }
__device__ __forceinline__ float bf2f(bf16_t v) { return __uint_as_float(((unsigned)v) << 16); }
__device__ __forceinline__ float bflo(unsigned w) { return __uint_as_float(w << 16); }
__device__ __forceinline__ float bfhi(unsigned w) { return __uint_as_float(w & 0xffff0000u); }
__device__ __forceinline__ int fresh_tid() { int t = threadIdx.x; asm volatile("" : "+v"(t)); return t; }
__device__ __forceinline__ float sigmoidf_(float x) { return __frcp_rn(1.0f + __expf(-x)); }
__device__ __forceinline__ void unpack8(const u32x4 v, float* f) { f[0] = bflo(v.x); f[1] = bfhi(v.x); f[2] = bflo(v.y); f[3] = bfhi(v.y); f[4] = bflo(v.z); f[5] = bfhi(v.z); f[6] = bflo(v.w); f[7] = bfhi(v.w); }
__device__ __forceinline__ u32x4 pack8(const float* f) { u32x4 w; w.x = cvt_pk_bf16(f[0], f[1]); w.y = cvt_pk_bf16(f[2], f[3]); w.z = cvt_pk_bf16(f[4], f[5]); w.w = cvt_pk_bf16(f[6], f[7]); return w; }

namespace pg8 {
constexpr int BM = 256, BK = 64, HALF = 128, HTB = HALF * BK * 2, STAGE_BYTES = 8 * HTB, NXCD = 8, WGM = 8;
__host__ __device__ __forceinline__ int lds_byte(int r, int c) { const int st = (r >> 4) * 2 + (c >> 5), rr = r & 15, cc = c & 31, ob = rr * 64 + cc * 2; return st * 1024 + (ob ^ (((ob >> 9) & 1) << 5)); }
__host__ __device__ __forceinline__ void stage_rc(int b, int& R, int& C) { const int st = b / 1024, sb = b % 1024, swz = sb ^ (((sb >> 9) & 1) << 5); R = (st >> 1) * 16 + swz / 64; C = (st & 1) * 32 + (swz % 64) / 2; }
__host__ __device__ __forceinline__ int perm32(int rho) { const int n = rho >> 4, i = rho & 15; return 8 * (i >> 2) + 4 * n + (i & 3); }

struct Unit { int pm, pn; const char* a; const char* b; };

template <class Epi, class Sched>
__device__ __forceinline__ void gemm_phase(LAS unsigned char* lds, const int K, const int lda, const Sched& S, const Epi& E, const int ldb_ = 0) {
    const int tid = fresh_tid(), wid = __builtin_amdgcn_readfirstlane(tid >> 6), lane = tid & 63, wr = wid >> 2, wc = wid & 3, fr = lane & 15, fq = lane >> 4;
    const int nt = K / BK;
    unsigned voffA[2], voffB[2];
#pragma unroll
    for (int i = 0; i < 2; ++i) { int R, C; stage_rc(tid * 16 + i * 8192, R, C); const int Rb = Epi::PERM ? ((R & ~31) + perm32(R & 31)) : R;
        voffA[i] = (unsigned)(R * lda + C) * 2u; voffB[i] = (unsigned)(Rb * (ldb_ ? ldb_ : K) + C) * 2u; }
    const size_t kstep = (size_t)(BK * 2);
    const size_t hstepA = (size_t)HALF * lda * 2, hstepB = (size_t)HALF * (ldb_ ? ldb_ : K) * 2;
    const unsigned ldsw = (unsigned)wid * 1024u;
    const int aoff = lds_byte(wr * 64 + fr, fq * 8), boff = lds_byte(wc * 32 + fr, fq * 8);
#define PG8_SA(b, h) (((b) * 2 + (h)) * HTB)
#define PG8_SB(b, h) ((4 + (b) * 2 + (h)) * HTB)
#define PG8_STAGE(bufoff, gbase, voff) do { _Pragma("unroll") for (int _i = 0; _i < 2; ++_i) \
        __builtin_amdgcn_global_load_lds((const unsigned*)((const char*)(gbase) + (voff)[_i]), (LAS unsigned*)(lds + (bufoff) + ldsw + _i * 8192), 16, 0, 0); } while (0)
#define PG8_LDA(dst, b, h) do { _Pragma("unroll") for (int m = 0; m < 4; ++m) _Pragma("unroll") for (int k = 0; k < 2; ++k) dst[m][k] = *(const LAS bf16x8*)(lds + PG8_SA(b, h) + aoff + m * 2048 + k * 1024); } while (0)
#define PG8_LDB(dst, b, h) do { _Pragma("unroll") for (int n = 0; n < 2; ++n) _Pragma("unroll") for (int k = 0; k < 2; ++k) dst[n][k] = *(const LAS bf16x8*)(lds + PG8_SB(b, h) + boff + n * 2048 + k * 1024); } while (0)
#define PG8_MMA(ai, bj, At, Bt) do { __builtin_amdgcn_s_setprio(1); _Pragma("unroll") for (int m = 0; m < 4; ++m) _Pragma("unroll") for (int n = 0; n < 2; ++n) _Pragma("unroll") for (int k = 0; k < 2; ++k) \
        acc[ai][bj][m][n] = __builtin_amdgcn_mfma_f32_16x16x32_bf16(Bt[n][k], At[m][k], acc[ai][bj][m][n], 0, 0, 0); __builtin_amdgcn_s_setprio(0); } while (0)
#define PG8_WAIT_V(n) asm volatile("s_waitcnt vmcnt(" #n ")" ::: "memory")
#define PG8_WAIT_L(n) asm volatile("s_waitcnt lgkmcnt(" #n ")" ::: "memory")
#define PG8_BAR __builtin_amdgcn_s_barrier()
#define PG8_SCHED __builtin_amdgcn_sched_barrier(0)
    Unit cur, nxt; int ui = 0;
    if (!S.next(0, cur)) return;
    f32x4 acc[2][2][4][2];
#pragma unroll
    for (int a = 0; a < 2; ++a)
#pragma unroll
        for (int b = 0; b < 2; ++b)
#pragma unroll
            for (int m = 0; m < 4; ++m)
#pragma unroll
                for (int n = 0; n < 2; ++n) acc[a][b][m][n] = (f32x4){0.f, 0.f, 0.f, 0.f};
    bf16x8 At[4][2], B0[2][2], B1[2][2];
    const char* cA = cur.a; const char* cB = cur.b;
    PG8_STAGE(PG8_SB(0, 0), cB, voffB); PG8_STAGE(PG8_SB(0, 1), cB + hstepB, voffB); PG8_STAGE(PG8_SA(0, 0), cA, voffA); PG8_STAGE(PG8_SA(0, 1), cA + hstepA, voffA);
    if (wr == 1) PG8_BAR;
    PG8_WAIT_V(2); PG8_BAR;
    PG8_STAGE(PG8_SB(1, 0), cB + kstep, voffB); PG8_STAGE(PG8_SA(1, 0), cA + kstep, voffA); PG8_STAGE(PG8_SB(1, 1), cB + hstepB + kstep, voffB);
    PG8_WAIT_V(6); PG8_BAR;
    for (;;) {
        const bool has_next = S.next(ui + 1, nxt);
        const char* nA = has_next ? nxt.a : cA; const char* nB = has_next ? nxt.b : cB;
        for (int t = 0; t < nt; t += 2) {
            const bool last = (t == nt - 2);
            const char* a1 = cA + (size_t)(t + 1) * kstep;
            const char* a2 = last ? nA : cA + (size_t)(t + 2) * kstep; const char* b2 = last ? nB : cB + (size_t)(t + 2) * kstep;
            const char* a3 = a2 + kstep; const char* b3 = b2 + kstep;
            PG8_LDB(B0, 0, 0); PG8_LDB(B1, 0, 1); PG8_SCHED; PG8_LDA(At, 0, 0); PG8_STAGE(PG8_SA(1, 1), a1 + hstepA, voffA);
            PG8_WAIT_V(8); PG8_WAIT_L(0); PG8_BAR; PG8_MMA(0, 0, At, B0); PG8_MMA(0, 1, At, B1); PG8_BAR; PG8_SCHED;
            PG8_LDA(At, 0, 1); PG8_STAGE(PG8_SB(0, 0), b2, voffB); PG8_STAGE(PG8_SB(0, 1), b2 + hstepB, voffB); PG8_STAGE(PG8_SA(0, 0), a2, voffA);
            PG8_WAIT_V(8); PG8_WAIT_L(0); PG8_BAR; PG8_MMA(1, 0, At, B0); PG8_MMA(1, 1, At, B1); PG8_BAR; PG8_SCHED;
            PG8_LDB(B0, 1, 0); PG8_LDB(B1, 1, 1); PG8_SCHED; PG8_LDA(At, 1, 0); PG8_STAGE(PG8_SA(0, 1), a2 + hstepA, voffA);
            PG8_WAIT_V(8); PG8_WAIT_L(0); PG8_BAR; PG8_MMA(0, 0, At, B0); PG8_MMA(0, 1, At, B1); PG8_BAR; PG8_SCHED;
            PG8_LDA(At, 1, 1); PG8_STAGE(PG8_SB(1, 0), b3, voffB); PG8_STAGE(PG8_SB(1, 1), b3 + hstepB, voffB); PG8_STAGE(PG8_SA(1, 0), a3, voffA);
            PG8_WAIT_V(8); PG8_WAIT_L(0); PG8_BAR; PG8_MMA(1, 0, At, B0); PG8_MMA(1, 1, At, B1); PG8_BAR; PG8_SCHED;
        }
        E(acc, cur, wr, wc, fr, fq);
        if (!has_next) break;
#pragma unroll
        for (int a = 0; a < 2; ++a)
#pragma unroll
            for (int b = 0; b < 2; ++b)
#pragma unroll
                for (int m = 0; m < 4; ++m)
#pragma unroll
                    for (int n = 0; n < 2; ++n) acc[a][b][m][n] = (f32x4){0.f, 0.f, 0.f, 0.f};
        cur = nxt; cA = nA; cB = nB; ++ui;
    }
    PG8_WAIT_V(0);
    if (wr == 0) PG8_BAR;
    PG8_BAR;
#undef PG8_SA
#undef PG8_SB
#undef PG8_STAGE
#undef PG8_LDA
#undef PG8_LDB
#undef PG8_MMA
#undef PG8_WAIT_V
#undef PG8_WAIT_L
#undef PG8_BAR
#undef PG8_SCHED
}

struct TileOrder {
    int nM, nN, nwg, G, c; const char* A; const char* Bt; size_t tA, tB;
    __device__ void init(int M, int N, int K, int lda, int G_, int c_, const void* A_, const void* Bt_) { nM = M / BM; nN = N / BM; nwg = nM * nN; G = G_; c = c_; A = (const char*)A_; Bt = (const char*)Bt_; tA = (size_t)BM * lda * 2; tB = (size_t)BM * K * 2; }
    __device__ bool next(int i, Unit& u) const {
        const long L = (long)i * G + c; if (L >= nwg) return false;
        int wgid = (int)L; { const int q = nwg / NXCD, r = nwg % NXCD, xcd = wgid % NXCD, off = wgid / NXCD; wgid = (xcd < r ? xcd * (q + 1) : r * (q + 1) + (xcd - r) * q) + off; }
        const int nig = WGM * nN, gid = wgid / nig, fm = gid * WGM, gsz = (nM - fm) < WGM ? (nM - fm) : WGM;
        u.pm = fm + ((wgid % nig) % gsz); u.pn = (wgid % nig) / gsz; u.a = A + (size_t)u.pm * tA; u.b = Bt + (size_t)u.pn * tB; return true;
    }
};
template <int TYPE> struct QkvOrder {
    int G, c; const char* A; const char* W;
    __device__ bool next(int i, Unit& u) const {
        const int L = i * G + c; if (L >= 68 * 4) return false;
        u.pm = L >> 2; u.pn = L & 3;
        u.a = A + ((size_t)u.pm * 256 * 1024 + u.pn * 256) * 2; u.b = W + (size_t)u.pn * 256 * 256 * 2; return true;
    }
};

struct EpiProj {
    static constexpr bool PERM = true;
    unsigned char* ws; const float* lbp;
    __device__ __forceinline__ void operator()(const f32x4 (&acc)[2][2][4][2], const Unit& u, int wr, int wc, int fr, int fq) const {
        const int ub = u.pn >> 2;
        bf16_t* base = (bf16_t*)(ws + (size_t)ub * UB);
        const int row0 = u.pm * BM + wr * 64 + fr, col0 = (u.pn & 3) * 256 + wc * 32 + 8 * fq;
        const int mode = (u.pm < 64) ? (ub == 3 ? 1 : (ub == 4 ? 2 : 0)) : 0;
        float lb[2][8];
        if (mode == 1) {
#pragma unroll
            for (int bj = 0; bj < 2; ++bj)
#pragma unroll
                for (int e = 0; e < 8; ++e) { const int c = col0 + bj * HALF + e; lb[bj][e] = __frcp_rn(1.0f + __expf(lbp[1024 + c] - lbp[c])); }
        }
#pragma unroll
        for (int ai = 0; ai < 2; ++ai)
#pragma unroll
            for (int m = 0; m < 4; ++m) { bf16_t* rowp = base + (size_t)(row0 + ai * HALF + m * 16) * 1024 + col0;
#pragma unroll
                for (int bj = 0; bj < 2; ++bj) { float v[8];
#pragma unroll
                    for (int e = 0; e < 4; ++e) { v[e] = acc[ai][bj][m][0][e]; v[4 + e] = acc[ai][bj][m][1][e]; }
                    if (mode == 1) {
#pragma unroll
                        for (int e = 0; e < 8; ++e) v[e] = __logf(lb[bj][e] + (1.0f - lb[bj][e]) * sigmoidf_(v[e]));
                    } else if (mode == 2) {
#pragma unroll
                        for (int e = 0; e < 8; ++e) v[e] = v[e] * sigmoidf_(v[e]);
                    }
                    *(u32x4*)(rowp + bj * HALF) = pack8(v); } }
    }
};
template <int TYPE> struct EpiQkv {
    static constexpr bool PERM = true;
    bf16_t* o;
    __device__ __forceinline__ void operator()(const f32x4 (&acc)[2][2][4][2], const Unit& u, int wr, int wc, int fr, int fq) const {
        constexpr int ld = TYPE ? 1024 : 512; constexpr size_t bjoff = TYPE ? 128 : (UB / 4);
        bf16_t* base = o + u.pn * (TYPE ? 256 : 128) + (size_t)(u.pm * BM + wr * 64 + fr) * ld + wc * 32 + 8 * fq;
#pragma unroll
        for (int ai = 0; ai < 2; ++ai)
#pragma unroll
            for (int m = 0; m < 4; ++m) { bf16_t* rowp = base + (size_t)(ai * HALF + m * 16) * ld;
#pragma unroll
                for (int bj = 0; bj < 2; ++bj) { const f32x4 v0 = acc[ai][bj][m][0], v1 = acc[ai][bj][m][1];
                    u32x4 w; w.x = cvt_pk_bf16(v0[0], v0[1]); w.y = cvt_pk_bf16(v0[2], v0[3]); w.z = cvt_pk_bf16(v1[0], v1[1]); w.w = cvt_pk_bf16(v1[2], v1[3]);
                    *(u32x4*)(rowp + bj * bjoff) = w; } }
    }
};
struct TailOrder {
    int c; const char* A; const char* Bt;
    __device__ bool next(int i, Unit& u) const {
        if (i > 0 || c >= 64) return false;
        const int un = c >> 2, sl = c & 3; u.pm = un & 3; u.pn = (un >> 2) | (sl << 4);
        u.a = A + (size_t)u.pm * 256 * 2048 * 2 + sl * 1024; u.b = Bt + (size_t)(un >> 2) * 256 * 2048 * 2 + sl * 1024; return true;
    }
};
struct EpiPart {
    static constexpr bool PERM = false;
    float* part;
    __device__ __forceinline__ void operator()(const f32x4 (&acc)[2][2][4][2], const Unit& u, int wr, int wc, int fr, int fq) const {
        const int row0 = u.pm * BM + wr * 64 + fr, col0 = (u.pn & 15) * BM + wc * 32 + 4 * fq;
        float* o = part + (size_t)(u.pn >> 4) * 1024 * 1024;
#pragma unroll
        for (int ai = 0; ai < 2; ++ai)
#pragma unroll
            for (int m = 0; m < 4; ++m) { const size_t ro = (size_t)(row0 + ai * HALF + m * 16) * 1024 + col0;
#pragma unroll
                for (int bj = 0; bj < 2; ++bj)
#pragma unroll
                    for (int n = 0; n < 2; ++n) *(f32x4*)(o + ro + bj * HALF + n * 16) = acc[ai][bj][m][n]; }
    }
};
struct EpiOut {
    static constexpr bool PERM = false;
    float* y; const float* x;
    __device__ __forceinline__ void operator()(const f32x4 (&acc)[2][2][4][2], const Unit& u, int wr, int wc, int fr, int fq) const {
        const int row0 = u.pm * BM + wr * 64 + fr, col0 = u.pn * BM + wc * 32 + 4 * fq;
#pragma unroll
        for (int ai = 0; ai < 2; ++ai)
#pragma unroll
            for (int m = 0; m < 4; ++m) { const size_t ro = (size_t)(row0 + ai * HALF + m * 16) * 1024 + col0;
#pragma unroll
                for (int bj = 0; bj < 2; ++bj)
#pragma unroll
                    for (int n = 0; n < 2; ++n) { const f32x4 xv = *(const f32x4*)(x + ro + bj * HALF + n * 16); *(f32x4*)(y + ro + bj * HALF + n * 16) = acc[ai][bj][m][n] + xv; } }
    }
};
}

__device__ __forceinline__ float wave_sum(float v) {
#pragma unroll
    for (int o = 32; o >= 1; o >>= 1) v += __shfl_xor(v, o);
    return v;
}

__device__ __forceinline__ void tr_tile(LAS float* tile, const float* __restrict__ src, int ld_src, bf16_t* __restrict__ dst, int ld_dst, int r0, int c0) {
    const int tid = threadIdx.x;
    { const int tr = tid >> 4, tc = (tid & 15) * 4;
#pragma unroll
      for (int i = 0; i < 2; ++i) { const int r = tr + 32 * i; const f32x4 v = *(const f32x4*)(src + (size_t)(r0 + r) * ld_src + c0 + tc);
          tile[r * 65 + tc] = v[0]; tile[r * 65 + tc + 1] = v[1]; tile[r * 65 + tc + 2] = v[2]; tile[r * 65 + tc + 3] = v[3]; } }
    __syncthreads();
    { const int c = tid >> 3, rg = (tid & 7) * 8; float f[8];
#pragma unroll
      for (int j = 0; j < 8; ++j) f[j] = tile[(rg + j) * 65 + c];
      *(u32x4*)(dst + (size_t)(c0 + c) * ld_dst + r0 + rg) = pack8(f); }
    __syncthreads();
}

__device__ __forceinline__ void phase_prep(const Params& p, LAS unsigned char* lds) {
    LAS float* tile = (LAS float*)lds;
    bf16_t* winT = (bf16_t*)((unsigned char*)p.out + YS_WIN);
    bf16_t* woutT = (bf16_t*)(p.ws + WS_WOUT);
    bf16_t* wqkT = (bf16_t*)(p.ws + WS_WQK);
    bf16_t* wvT = (bf16_t*)(p.ws + WS_WV);
    bf16_t* xn = (bf16_t*)((unsigned char*)p.out + YS_XN);
    constexpr int T_WIN = 16 * 112, T_WOUT = 32 * 16, T_WQ = 32, T_WK = 32, T_WV = 64;
    constexpr int T_ALL = T_WIN + T_WOUT + T_WQ + T_WK + T_WV, XN_GROUPS = NROWS / 8;
    for (int w = blockIdx.x; w < T_ALL + XN_GROUPS; w += gridDim.x) {
        if (w < T_ALL) {
            int t = w;
            if (t < T_WIN) { tr_tile(tile, p.w_in, 7168, winT, 1024, (t & 15) * 64, (t >> 4) * 64); continue; }
            t -= T_WIN;
            if (t < T_WOUT) { tr_tile(tile, p.w_out, 1024, woutT, 2048, (t & 31) * 64, (t >> 5) * 64); continue; }
            t -= T_WOUT;
            if (t < T_WQ) { const int h = t >> 3, tt = t & 7; tr_tile(tile, p.w_q + (size_t)h * 256 * 128, 128, wqkT + (size_t)h * 65536, 256, (tt & 3) * 64, (tt >> 2) * 64); continue; }
            t -= T_WQ;
            if (t < T_WK) { const int h = t >> 3, tt = t & 7; tr_tile(tile, p.w_k + (size_t)h * 256 * 128, 128, wqkT + (size_t)h * 65536 + 128 * 256, 256, (tt & 3) * 64, (tt >> 2) * 64); continue; }
            t -= T_WK;
            { const int h = t >> 4, tt = t & 15; tr_tile(tile, p.w_v + (size_t)h * 65536, 256, wvT + (size_t)h * 65536, 256, (tt & 3) * 64, (tt >> 2) * 64); }
        } else {
            const int r = (w - T_ALL) * 8 + (threadIdx.x >> 6), lane = threadIdx.x & 63;
            const float* src = (r < NROWS_P) ? p.x_prompt + (size_t)r * 1024 : p.x_sample + (size_t)(r - NROWS_P) * 1024;
            f32x4 v[4]; float ss = 0.f;
#pragma unroll
            for (int i = 0; i < 4; ++i) { v[i] = *(const f32x4*)(src + lane * 4 + 256 * i); ss += v[i][0] * v[i][0] + v[i][1] * v[i][1] + v[i][2] * v[i][2] + v[i][3] * v[i][3]; }
            ss = wave_sum(ss);
            const float rstd = rsqrtf(ss * (1.0f / 1024.0f) + 1e-6f);
#pragma unroll
            for (int i = 0; i < 4; ++i) { const f32x4 g = *(const f32x4*)(p.g_norm + lane * 4 + 256 * i);
                u32x2 w; w.x = cvt_pk_bf16(v[i][0] * rstd * g[0], v[i][1] * rstd * g[1]); w.y = cvt_pk_bf16(v[i][2] * rstd * g[2], v[i][3] * rstd * g[3]);
                *(u32x2*)(xn + (size_t)r * 1024 + lane * 4 + 256 * i) = w; }
        }
    }
}

__device__ __forceinline__ void phase_conv(const Params& p) {
    const bf16_t* xm = (const bf16_t*)(p.ws + WS_U0);
    bf16_t* xc = (bf16_t*)((unsigned char*)p.out + YS_XC);
    const int nthreads = gridDim.x * blockDim.x;
    for (int idx = blockIdx.x * blockDim.x + fresh_tid(); idx < NROWS * 128; idx += nthreads) {
        const int r = idx >> 7, c0 = (idx & 127) * 8;
        int b, t; const bool samp = r >= NROWS_P;
        if (!samp) { b = r >> 11; t = r & 2047; } else { b = (r - NROWS_P) >> 3; t = (r - NROWS_P) & 7; }
        float accv[8];
        { const f32x4 b0 = *(const f32x4*)(p.conv_b + c0), b1 = *(const f32x4*)(p.conv_b + c0 + 4);
          accv[0] = b0[0]; accv[1] = b0[1]; accv[2] = b0[2]; accv[3] = b0[3]; accv[4] = b1[0]; accv[5] = b1[1]; accv[6] = b1[2]; accv[7] = b1[3]; }
        float cur[8];
#pragma unroll
        for (int j = 0; j < 4; ++j) {
            const int tt = t - 3 + j; float xv[8];
            if (tt >= 0) { unpack8(*(const u32x4*)(xm + (size_t)(r - 3 + j) * 1024 + c0), xv); }
            else if (samp) { const float* s = p.st_conv + ((size_t)b * 3 + (t + j)) * 1024 + c0; const f32x4 s0 = *(const f32x4*)s, s1 = *(const f32x4*)(s + 4);
                xv[0] = s0[0]; xv[1] = s0[1]; xv[2] = s0[2]; xv[3] = s0[3]; xv[4] = s1[0]; xv[5] = s1[1]; xv[6] = s1[2]; xv[7] = s1[3]; }
            else {
#pragma unroll
                for (int e = 0; e < 8; ++e) xv[e] = 0.f; }
            const f32x4 w0 = *(const f32x4*)(p.conv_w + j * 1024 + c0), w1 = *(const f32x4*)(p.conv_w + j * 1024 + c0 + 4);
            accv[0] += w0[0] * xv[0]; accv[1] += w0[1] * xv[1]; accv[2] += w0[2] * xv[2]; accv[3] += w0[3] * xv[3];
            accv[4] += w1[0] * xv[4]; accv[5] += w1[1] * xv[5]; accv[6] += w1[2] * xv[6]; accv[7] += w1[3] * xv[7];
            if (j == 3) {
#pragma unroll
                for (int e = 0; e < 8; ++e) cur[e] = xv[e]; }
        }
#pragma unroll
        for (int e = 0; e < 8; ++e) accv[e] = accv[e] * sigmoidf_(accv[e]);
        *(u32x4*)(xc + (size_t)r * 1024 + c0) = pack8(accv);
        float* cdst = nullptr;
        if (!samp) { if (t >= 2045) cdst = p.out + O_PCONV + ((size_t)b * 3 + (t - 2045)) * 1024 + c0; }
        else { if (t >= 5) cdst = p.out + O_SCONV + ((size_t)b * 3 + (t - 5)) * 1024 + c0; }
        if (cdst) { *(f32x4*)cdst = (f32x4){cur[0], cur[1], cur[2], cur[3]}; *(f32x4*)(cdst + 4) = (f32x4){cur[4], cur[5], cur[6], cur[7]}; }
    }
}

__device__ __forceinline__ void phase_gates(const Params& p, LAS unsigned char* lds) {
    LAS f32x4* wgA = (LAS f32x4*)lds;
    LAS f32x4* wgB = wgA + 2048;
    for (int i = threadIdx.x; i < 2048; i += blockDim.x) {
        const f32x4 a = *(const f32x4*)(p.w_gate + (size_t)i * 8), b = *(const f32x4*)(p.w_gate + (size_t)i * 8 + 4);
        const int slot = (i & 7) * 256 + (i >> 3); wgA[slot] = a; wgB[slot] = b; }
    __syncthreads();
    const bf16_t* q = (const bf16_t*)((unsigned char*)p.out + YS_Q);
    const bf16_t* k = (const bf16_t*)((unsigned char*)p.out + YS_K);
    const bf16_t* v = (const bf16_t*)(p.ws + WS_U0);
    float* gates = (float*)(p.ws + WS_GATES);
    const int tid = fresh_tid(), lane = tid & 63, wave = blockIdx.x * 8 + (tid >> 6), nw = gridDim.x * 8;
    for (int r = wave; r < NROWS; r += nw) {
        u32x4 d[4];
        d[0] = *(const u32x4*)(q + (size_t)r * 512 + lane * 8); d[1] = *(const u32x4*)(k + (size_t)r * 512 + lane * 8);
        d[2] = *(const u32x4*)(v + (size_t)r * 1024 + lane * 8); d[3] = *(const u32x4*)(v + (size_t)r * 1024 + 512 + lane * 8);
        f32x4 ga = (f32x4){0.f, 0.f, 0.f, 0.f}, gb = ga;
#pragma unroll 1
        for (int c = 0; c < 4; ++c) { float f[8]; unpack8(d[c], f);
#pragma unroll
            for (int j = 0; j < 8; ++j) { const int slot = j * 256 + c * 64 + lane; ga += wgA[slot] * f[j]; gb += wgB[slot] * f[j]; } }
        float g8[8] = {ga[0], ga[1], ga[2], ga[3], gb[0], gb[1], gb[2], gb[3]};
#pragma unroll
        for (int j = 0; j < 8; ++j) g8[j] = wave_sum(g8[j]);
        if (lane < 8) {
            float val = g8[0];
#pragma unroll
            for (int j = 1; j < 8; ++j) val = (lane == j) ? g8[j] : val;
            val += p.b_gate[lane];
            if (lane >= 4) val = fminf(val, 0.f) - __logf(1.0f + __expf(-fabsf(val)));
            gates[(size_t)r * 8 + lane] = val;
        }
    }
    __syncthreads();
}

__device__ __forceinline__ void phase_post(const Params& p) {
    const bf16_t* num = (const bf16_t*)(p.ws + WS_U0);
    const bf16_t* zm = (const bf16_t*)(p.ws + WS_U0 + UB);
    const bf16_t* om = (const bf16_t*)(p.ws + WS_U0 + 2 * UB);
    const bf16_t* oh = (const bf16_t*)(p.ws + WS_U0 + 5 * UB);
    const bf16_t* zh = (const bf16_t*)(p.ws + WS_U0 + 6 * UB);
    const bf16_t* xc = (const bf16_t*)((unsigned char*)p.out + YS_XC);
    bf16_t* mix = (bf16_t*)(p.ws + WS_U0 + 3 * UB);
    const float* den = (const float*)(p.ws + WS_DEN);
    const float* mt = (const float*)(p.ws + WS_MT);
    const int tid = fresh_tid(), lane = tid & 63, wave = blockIdx.x * 8 + (tid >> 6), nw = gridDim.x * 8;
    const int c0 = lane * 16;
    for (int r = wave; r < NROWS; r += nw) {
        {
            const int h = lane >> 4;
            float x[16], t[16];
            unpack8(*(const u32x4*)(num + (size_t)r * 1024 + c0), x); unpack8(*(const u32x4*)(num + (size_t)r * 1024 + c0 + 8), x + 8);
            const float dn = den[(size_t)r * 4 + h], m = mt[(size_t)r * 4 + h];
            const float inv = __frcp_rn(fmaxf(fabsf(dn), __expf(-m)));
            float s = 0.f;
#pragma unroll
            for (int j = 0; j < 16; ++j) { x[j] *= inv; s += x[j]; }
            s += __shfl_xor(s, 1); s += __shfl_xor(s, 2); s += __shfl_xor(s, 4); s += __shfl_xor(s, 8);
            const float mu = s * (1.0f / 256.0f);
            float vs = 0.f;
#pragma unroll
            for (int j = 0; j < 16; ++j) { x[j] -= mu; vs += x[j] * x[j]; }
            vs += __shfl_xor(vs, 1); vs += __shfl_xor(vs, 2); vs += __shfl_xor(vs, 4); vs += __shfl_xor(vs, 8);
            const float rstd = rsqrtf(vs * (1.0f / 256.0f) + 1e-6f);
            unpack8(*(const u32x4*)(om + (size_t)r * 1024 + c0), t); unpack8(*(const u32x4*)(om + (size_t)r * 1024 + c0 + 8), t + 8);
#pragma unroll
            for (int j = 0; j < 16; ++j) x[j] = x[j] * rstd * p.m_ln[c0 + j] * sigmoidf_(t[j]);
            unpack8(*(const u32x4*)(xc + (size_t)r * 1024 + c0), t); unpack8(*(const u32x4*)(xc + (size_t)r * 1024 + c0 + 8), t + 8);
#pragma unroll
            for (int j = 0; j < 16; ++j) x[j] += p.m_skip[c0 + j] * t[j];
            unpack8(*(const u32x4*)(zm + (size_t)r * 1024 + c0), t); unpack8(*(const u32x4*)(zm + (size_t)r * 1024 + c0 + 8), t + 8);
#pragma unroll
            for (int j = 0; j < 16; ++j) x[j] *= t[j] * sigmoidf_(t[j]);
            *(u32x4*)(mix + (size_t)r * 2048 + c0) = pack8(x); *(u32x4*)(mix + (size_t)r * 2048 + c0 + 8) = pack8(x + 8);
        }
        {
            float x[16], t[16];
            unpack8(*(const u32x4*)(oh + (size_t)r * 1024 + c0), x); unpack8(*(const u32x4*)(oh + (size_t)r * 1024 + c0 + 8), x + 8);
            float s = 0.f;
#pragma unroll
            for (int j = 0; j < 16; ++j) s += x[j] * x[j];
            s += __shfl_xor(s, 1); s += __shfl_xor(s, 2); s += __shfl_xor(s, 4);
            const float rstd = rsqrtf(s * (1.0f / 128.0f) + 1e-6f);
            unpack8(*(const u32x4*)(zh + (size_t)r * 1024 + c0), t); unpack8(*(const u32x4*)(zh + (size_t)r * 1024 + c0 + 8), t + 8);
#pragma unroll
            for (int j = 0; j < 16; ++j) x[j] = x[j] * rstd * p.h_norm[c0 + j] * t[j] * sigmoidf_(t[j]);
            *(u32x4*)(mix + (size_t)r * 2048 + 1024 + c0) = pack8(x); *(u32x4*)(mix + (size_t)r * 2048 + 1024 + c0 + 8) = pack8(x + 8);
        }
    }
}

template <bool PARTS>
__device__ __forceinline__ void phase_final(const Params& p, const int rbeg, const int rend, const int blk0, const int nblk) {
    float* y = p.out + O_Y;
    const int tid = fresh_tid(), lane = tid & 63, wave = ((int)blockIdx.x - blk0) * 8 + (tid >> 6), nw = nblk * 8;
    for (int r = rbeg + wave; r < rend; r += nw) {
        f32x4 v[4]; float ss = 0.f;
#pragma unroll
        for (int i = 0; i < 4; ++i) {
            if (PARTS) { const size_t o = (size_t)(r - NROWS_P) * 1024 + lane * 4 + 256 * i; const float* pt = (const float*)(p.ws + WS_U0);
                v[i] = *(const f32x4*)(p.x_sample + o) + *(const f32x4*)(pt + o) + *(const f32x4*)(pt + 1048576 + o) + *(const f32x4*)(pt + 2 * 1048576 + o) + *(const f32x4*)(pt + 3 * 1048576 + o); }
            else v[i] = *(const f32x4*)(y + (size_t)r * 1024 + lane * 4 + 256 * i);
            ss += v[i][0] * v[i][0] + v[i][1] * v[i][1] + v[i][2] * v[i][2] + v[i][3] * v[i][3]; }
        ss = wave_sum(ss);
        const float rstd = rsqrtf(ss * (1.0f / 1024.0f) + 1e-6f);
#pragma unroll
        for (int i = 0; i < 4; ++i) { const f32x4 g = *(const f32x4*)(p.g_final + lane * 4 + 256 * i);
            *(f32x4*)(y + (size_t)r * 1024 + lane * 4 + 256 * i) = v[i] * rstd * g; }
    }
}

constexpr int QS = 272, K2S = 320, VS = 192, PS = 144;
constexpr int OFF_Q1 = 0, OFF_Q2 = 17408, OFF_KX = 34816, OFF_K2 = 52224, OFF_V = 72704, OFF_P = 84992, OFF_CT = 94208, OFF_VEC = 120320, OFF_B = 123392, OFF_TOT = 156160;
#define MFMA32(a, b, c) __builtin_amdgcn_mfma_f32_32x32x16_bf16((a), (b), (c), 0, 0, 0)
__device__ __forceinline__ int crow(int reg, int lane) { return (reg & 3) + 8 * (reg >> 2) + 4 * (lane >> 5); }
typedef short s16x4 __attribute__((ext_vector_type(4)));
__device__ __forceinline__ bf16x8 tr_frag(unsigned a0, unsigned a1) {
    s16x4 lo, hi;
    asm volatile("ds_read_b64_tr_b16 %0, %2\n\tds_read_b64_tr_b16 %1, %3\n\ts_waitcnt lgkmcnt(0)" : "=&v"(lo), "=&v"(hi) : "v"(a0), "v"(a1) : "memory");
    return (bf16x8){lo[0], lo[1], lo[2], lo[3], hi[0], hi[1], hi[2], hi[3]};
}

__device__ __forceinline__ void tr_frag4(const unsigned a0, const int S, bf16x8 (&f)[4]) {
    s16x4 r0, r1, r2, r3, r4, r5, r6, r7;
    const unsigned a1 = a0 + 4 * S, a2 = a0 + 16 * S, a3 = a0 + 20 * S, a4 = a0 + 32 * S, a5 = a0 + 36 * S, a6 = a0 + 48 * S, a7 = a0 + 52 * S;
    asm volatile("ds_read_b64_tr_b16 %0, %8\n\tds_read_b64_tr_b16 %1, %9\n\tds_read_b64_tr_b16 %2, %10\n\tds_read_b64_tr_b16 %3, %11\n\t"
                 "ds_read_b64_tr_b16 %4, %12\n\tds_read_b64_tr_b16 %5, %13\n\tds_read_b64_tr_b16 %6, %14\n\tds_read_b64_tr_b16 %7, %15\n\ts_waitcnt lgkmcnt(0)"
                 : "=&v"(r0), "=&v"(r1), "=&v"(r2), "=&v"(r3), "=&v"(r4), "=&v"(r5), "=&v"(r6), "=&v"(r7)
                 : "v"(a0), "v"(a1), "v"(a2), "v"(a3), "v"(a4), "v"(a5), "v"(a6), "v"(a7) : "memory");
    f[0] = (bf16x8){r0[0], r0[1], r0[2], r0[3], r1[0], r1[1], r1[2], r1[3]}; f[1] = (bf16x8){r2[0], r2[1], r2[2], r2[3], r3[0], r3[1], r3[2], r3[3]};
    f[2] = (bf16x8){r4[0], r4[1], r4[2], r4[3], r5[0], r5[1], r5[2], r5[3]}; f[3] = (bf16x8){r6[0], r6[1], r6[2], r6[3], r7[0], r7[1], r7[2], r7[3]};
}

template <int NT, bool IS_M>
__device__ __forceinline__ void scan_item(const Params& p, LAS unsigned char* lds, const int b, const int h, const int sl) {
    const int tid = fresh_tid(), wid = __builtin_amdgcn_readfirstlane(tid >> 6), lane = tid & 63, l31 = lane & 31, lh = lane >> 5;
    constexpr int nch = 32; const int row0 = b * 2048;
    LAS float* vec = (LAS float*)(lds + OFF_VEC);
    const unsigned ldsb = (unsigned)(size_t)lds;
    const bf16_t* gq; const bf16_t* gk; bf16_t* gv; int ldq; constexpr int ldv = 1024;
    if (IS_M) { gq = (const bf16_t*)((unsigned char*)p.out + YS_Q) + h * 128; gk = (const bf16_t*)((unsigned char*)p.out + YS_K) + h * 128; ldq = 512;
                gv = (bf16_t*)(p.ws + WS_U0) + h * 256 + sl * 64; }
    else { gq = (const bf16_t*)(p.ws + WS_U0 + 4 * UB) + h * 128; gk = (const bf16_t*)(p.ws + WS_U0 + 3 * UB) + h * 128; ldq = 1024;
           gv = (bf16_t*)(p.ws + WS_U0 + 5 * UB) + h * 128 + sl * 64; }
    const float* gates = (const float*)(p.ws + WS_GATES);
    const int kc = (tid & 15) * 8, tq = tid >> 4;
    const int dc = (tid & 7) * 8, tv = tid >> 3;
    const int trow = 8 * lh + ((lane & 15) >> 2), tcolb = (16 * ((lane >> 4) & 1) + 4 * (lane & 3)) * 2;
    if (!IS_M) { if (tid < 128) { const float p0 = p.lb_param[h * 128 + tid], p1 = p.lb_param[1024 + h * 128 + tid]; const float lb = __frcp_rn(1.0f + __expf(p1 - p0)); vec[384 + tid] = lb; vec[512 + tid] = 1.0f - lb; } }
    f32x16 st[NT];
#pragma unroll
    for (int j = 0; j < NT; ++j)
#pragma unroll
        for (int r = 0; r < 16; ++r) st[j][r] = 0.f;
    for (int i = tid; i < NT * 32 * QS / 16; i += 512) *(LAS u32x4*)(lds + OFF_CT + i * 16) = (u32x4){0u, 0u, 0u, 0u};
    if (IS_M) {
        if (tid < 64) { unsigned one = 0x3F80u; asm volatile("" : "+v"(one));
#pragma unroll
            for (int i = 0; i < 4; ++i) *(LAS u32x4*)(lds + OFF_V + tid * VS + 128 + 16 * i) = (u32x4){(i == 0) ? one : 0u, 0u, 0u, 0u}; }
    }
    LAS unsigned char* outb = lds + (IS_M ? OFF_B : OFF_CT + 64 * QS);
    LAS float* glds = (LAS float*)(lds + OFF_B + 8192); LAS float* dmt = (LAS float*)(lds + OFF_B + 8192 + 16384);
    if (IS_M) { for (int i = tid; i < 2048; i += 512) { const size_t gr = (size_t)(row0 + i) * 8; glds[2 * i] = gates[gr + h]; glds[2 * i + 1] = gates[gr + 4 + h]; } }
    __syncthreads();
    float m_run = 0.f;
    auto gate_vectors = [&](const int c) {
        LAS float* vb = vec + (c & 1) * 320;
        const float ig = glds[2 * (c * 64 + lane)], lf = glds[2 * (c * 64 + lane) + 1];
        float bc = lf;
#pragma unroll
        for (int o = 1; o < 64; o <<= 1) { const float u = __shfl_up(bc, o); if (lane >= o) bc += u; }
        const float a = ig - bc;
        float M = fmaxf(a, m_run);
#pragma unroll
        for (int o = 1; o < 64; o <<= 1) { const float u = __shfl_up(M, o); if (lane >= o) M = fmaxf(M, u); }
        const float M63 = __shfl(M, 63), b63 = __shfl(bc, 63);
        vb[lane] = a; vb[64 + lane] = M; vb[128 + lane] = __expf(M63 - M) * 0.08838834764831845f; vb[192 + lane] = __expf(a - M63);
        if (lane == 0) vb[256] = __expf(m_run - M63);
        vb[257 + lane] = bc + M;
        m_run = b63 + M63;
    };
    if (IS_M && wid == 7) gate_vectors(0);
    u32x4 rq[2], rk[2], rv;
#pragma unroll
    for (int i = 0; i < 2; ++i) { const unsigned ro = (unsigned)((row0 + tq + 32 * i) * ldq + kc); rq[i] = *(const u32x4*)(gq + ro); rk[i] = *(const u32x4*)(gk + ro); }
    rv = *(const u32x4*)(gv + (unsigned)((row0 + tv) * ldv + dc));
    __syncthreads();

#pragma unroll 1
    for (int c = 0; c < nch; ++c) {
        const int t0 = c * 64;
        LAS float* vb = vec + (c & 1) * 320;
        if (IS_M) {
#pragma unroll
            for (int i = 0; i < 2; ++i) { const int t = tq + 32 * i; float f[8], g[8];
                *(LAS u32x4*)(lds + OFF_KX + t * QS + kc * 2) = rk[i];
                unpack8(rq[i], f); const float gs = vb[128 + t];
#pragma unroll
                for (int j = 0; j < 8; ++j) g[j] = f[j] * gs;
                *(LAS u32x4*)(lds + OFF_Q1 + t * QS + kc * 2) = pack8(g);
                unpack8(rk[i], f); const float ws_ = vb[192 + t];
#pragma unroll
                for (int j = 0; j < 8; ++j) g[j] = f[j] * ws_;
                *(LAS u32x4*)(lds + OFF_K2 + t * K2S + kc * 2) = pack8(g);
            }
        } else {
            LAS float* Bf = (LAS float*)(lds + OFF_B); LAS float* tot = (LAS float*)(lds + OFF_TOT);
#pragma unroll
            for (int i = 0; i < 2; ++i) { const int t = tq + 32 * i; float f[8]; unpack8(rk[i], f);
                *(LAS f32x4*)(Bf + t * 128 + kc) = (f32x4){f[0], f[1], f[2], f[3]}; *(LAS f32x4*)(Bf + t * 128 + kc + 4) = (f32x4){f[4], f[5], f[6], f[7]}; }
            __syncthreads();
            { const int k = tid & 127, seg = tid >> 7; float run = 0.f;
#pragma unroll
              for (int t = 0; t < 16; ++t) { run += Bf[(seg * 16 + t) * 128 + k]; Bf[(seg * 16 + t) * 128 + k] = run; }
              tot[seg * 128 + k] = run; }
            __syncthreads();
            float t0s[8], t1s[8], t2s[8], bmid[8], blast[8];
#pragma unroll
            for (int j = 0; j < 8; ++j) { const int k = kc + j; t0s[j] = tot[k]; t1s[j] = tot[128 + k]; t2s[j] = tot[256 + k]; bmid[j] = Bf[31 * 128 + k] + t0s[j]; blast[j] = Bf[63 * 128 + k] + t0s[j] + t1s[j] + t2s[j]; }
            const bool hiseg = (tq >= 16);
#pragma unroll
            for (int i = 0; i < 2; ++i) { const int t = tq + 32 * i; float fq[8], ff[8], q1[8], q2[8], kx[8], k2[8];
                unpack8(rq[i], fq); unpack8(rk[i], ff);
#pragma unroll
                for (int j = 0; j < 8; ++j) {
                    const float pre = (i == 0) ? (hiseg ? t0s[j] : 0.f) : (hiseg ? t0s[j] + t1s[j] + t2s[j] : t0s[j] + t1s[j]);
                    const float bb = Bf[t * 128 + kc + j] + pre;
                    const float qv = fq[j], kv = 1.0f - __expf(ff[j]);
                    q1[j] = qv * __expf(bb - bmid[j]); q2[j] = qv * __expf(bb); kx[j] = kv * __expf(bmid[j] - bb); k2[j] = kv * __expf(blast[j] - bb);
                }
                *(LAS u32x4*)(lds + OFF_Q1 + t * QS + kc * 2) = pack8(q1);
                *(LAS u32x4*)(lds + OFF_Q2 + t * QS + kc * 2) = pack8(q2);
                *(LAS u32x4*)(lds + OFF_KX + t * QS + kc * 2) = pack8(kx);
                *(LAS u32x4*)(lds + OFF_K2 + t * K2S + kc * 2) = pack8(k2);
            }
            if (tq == 0) {
#pragma unroll
                for (int j = 0; j < 8; ++j) vec[kc + j] = __expf(blast[j]); }
        }
        *(LAS u32x4*)(lds + OFF_V + tv * VS + dc * 2) = rv;
        if (c > 0) {
            *(u32x4*)(gv + (unsigned)((row0 + t0 - 64 + tv) * ldv + dc)) = *(const LAS u32x4*)(outb + tv * 128 + dc * 2);
            if (IS_M && sl == 0 && tid < 64) { ((float*)(p.ws + WS_DEN))[(size_t)(row0 + t0 - 64 + tid) * 4 + h] = dmt[tid]; ((float*)(p.ws + WS_MT))[(size_t)(row0 + t0 - 64 + tid) * 4 + h] = vec[((c - 1) & 1) * 320 + 257 + tid]; }
        }
        if (c + 1 < nch) {
#pragma unroll
            for (int i = 0; i < 2; ++i) { const unsigned ro = (unsigned)((row0 + t0 + 64 + tq + 32 * i) * ldq + kc); rq[i] = *(const u32x4*)(gq + ro); rk[i] = *(const u32x4*)(gk + ro); }
            rv = *(const u32x4*)(gv + (unsigned)((row0 + t0 + 64 + tv) * ldv + dc));
        }
        __syncthreads();
        const int kb = lh * 16;
        constexpr int NU = (2 * NT + 3) / 4;
        f32x16 oacc[NU];
        if (wid < 4) {
            const int ti = wid >> 1, si = wid & 1;
            f32x16 sacc;
#pragma unroll
            for (int r = 0; r < 16; ++r) sacc[r] = 0.f;
            if (si <= ti) {
#pragma unroll
                for (int ks = 0; ks < 8; ++ks) { const bf16x8 a = *(const LAS bf16x8*)(lds + OFF_Q1 + (ti * 32 + l31) * QS + ks * 32 + kb), bb = *(const LAS bf16x8*)(lds + OFF_KX + (si * 32 + l31) * QS + ks * 32 + kb);
                    sacc = MFMA32(a, bb, sacc); }
            }
            const int s = si * 32 + l31; const float ws_s = IS_M ? vb[192 + s] : 1.0f;
#pragma unroll
            for (int r = 0; r < 16; ++r) { const int t = ti * 32 + crow(r, lane); float pv;
                if (IS_M) pv = (s <= t) ? sacc[r] * ws_s : 0.f; else pv = (s <= t) ? sacc[r] : 0.f;
                *(LAS bf16_t*)(lds + OFF_P + t * PS + s * 2) = f2bf(pv); }
        } else {
#pragma unroll
            for (int u = 0; u < NU; ++u) { const int tile = (wid - 4) + 4 * u;
#pragma unroll
                for (int r = 0; r < 16; ++r) oacc[u][r] = 0.f;
                if (tile < 2 * NT) { const int ti = tile & 1, j = tile >> 1;
#pragma unroll
                    for (int ks = 0; ks < 8; ++ks) { const bf16x8 a = *(const LAS bf16x8*)(lds + (IS_M ? OFF_Q1 : OFF_Q2) + (ti * 32 + l31) * QS + ks * 32 + kb), bb = *(const LAS bf16x8*)(lds + OFF_CT + (j * 32 + l31) * QS + ks * 32 + kb);
                        oacc[u] = MFMA32(a, bb, oacc[u]); }
                    if (IS_M) { const float dcy = vb[256];
#pragma unroll
                        for (int r = 0; r < 16; ++r) oacc[u][r] *= dcy; } } }
        }
        __syncthreads();
        if (wid < 4) {
            float dec[IS_M ? 1 : 16];
            if (IS_M) dec[0] = vb[256];
            else {
#pragma unroll
                for (int r = 0; r < 16; ++r) dec[r] = vec[wid * 32 + crow(r, lane)]; }
            bf16x8 a[4];
            tr_frag4(ldsb + OFF_K2 + trow * K2S + wid * 64 + tcolb, K2S, a);
#pragma unroll
            for (int j = 0; j < NT; ++j) {
                bf16x8 bv[4];
                tr_frag4(ldsb + OFF_V + trow * VS + j * 64 + tcolb, VS, bv);
#pragma unroll
                for (int r = 0; r < 16; ++r) st[j][r] *= dec[IS_M ? 0 : r];
#pragma unroll
                for (int ks = 0; ks < 4; ++ks) st[j] = MFMA32(a[ks], bv[ks], st[j]);
#pragma unroll
                for (int g = 0; g < 4; ++g) { u32x2 w; w.x = cvt_pk_bf16(st[j][4 * g], st[j][4 * g + 1]); w.y = cvt_pk_bf16(st[j][4 * g + 2], st[j][4 * g + 3]);
                    *(LAS u32x2*)(lds + OFF_CT + (j * 32 + l31) * QS + (wid * 32 + 8 * g + 4 * lh) * 2) = w; }
            }
        } else {
#pragma unroll
            for (int u = 0; u < NU; ++u) { const int tile = (wid - 4) + 4 * u;
                if (tile < 2 * NT) { const int ti = tile & 1, j = tile >> 1;
                    bf16x8 pa[4], bv[4];
#pragma unroll
                    for (int ks = 0; ks < 4; ++ks) pa[ks] = *(const LAS bf16x8*)(lds + OFF_P + (ti * 32 + l31) * PS + ks * 32 + kb);
                    tr_frag4(ldsb + OFF_V + trow * VS + j * 64 + tcolb, VS, bv);
#pragma unroll
                    for (int ks = 0; ks < 4; ++ks) oacc[u] = MFMA32(pa[ks], bv[ks], oacc[u]);
                    if (j < 2) {
#pragma unroll
                        for (int r = 0; r < 16; ++r) { const int t = ti * 32 + crow(r, lane); *(LAS bf16_t*)(outb + t * 128 + (j * 32 + l31) * 2) = f2bf(oacc[u][r]); }
                    } else if (IS_M && l31 == 0) {
#pragma unroll
                        for (int r = 0; r < 16; ++r) { const int t = ti * 32 + crow(r, lane); dmt[t] = oacc[u][r]; }
                    } } }
            if (IS_M && wid == 7 && c + 1 < nch) gate_vectors(c + 1);
        }
        __syncthreads();
    }
    const int tid2 = fresh_tid(), lane2 = tid2 & 63, l31b = lane2 & 31, wid2 = __builtin_amdgcn_readfirstlane(tid2 >> 6);
    { const int tv2 = tid2 >> 3, dc2 = (tid2 & 7) * 8;
      *(u32x4*)(gv + (unsigned)((row0 + 2048 - 64 + tv2) * ldv + dc2)) = *(const LAS u32x4*)(outb + tv2 * 128 + dc2 * 2); }
    if (IS_M && sl == 0 && tid2 < 64) { ((float*)(p.ws + WS_DEN))[(size_t)(row0 + 2048 - 64 + tid2) * 4 + h] = dmt[tid2]; ((float*)(p.ws + WS_MT))[(size_t)(row0 + 2048 - 64 + tid2) * 4 + h] = vec[((nch - 1) & 1) * 320 + 257 + tid2]; }
    if (wid2 < 4) {
        float* Cout; float* nout = nullptr; int ldc;
        if (IS_M) { Cout = p.out + O_PC + ((size_t)b * 4 + h) * 128 * 256 + sl * 64; ldc = 256; nout = p.out + O_PN + ((size_t)b * 4 + h) * 128; }
        else { Cout = p.out + O_PS + ((size_t)b * 8 + h) * 128 * 128 + sl * 64; ldc = 128; }
#pragma unroll
        for (int j = 0; j < NT; ++j)
#pragma unroll
            for (int r = 0; r < 16; ++r) { const int dk = wid2 * 32 + crow(r, lane2);
                if (j < 2) Cout[(size_t)dk * ldc + j * 32 + l31b] = st[j][r];
                else if (IS_M && sl == 0 && l31b == 0) nout[dk] = st[j][r]; }
    }
    if (IS_M && sl == 0 && tid2 == 448) p.out[O_PM + b * 4 + h] = m_run;
    __syncthreads();
}

__device__ __forceinline__ f32x4 bf4_to_f32(const u32x2 w) { return (f32x4){bflo(w.x), bfhi(w.x), bflo(w.y), bfhi(w.y)}; }
__device__ __forceinline__ void sample_mlstm(const Params& p, LAS unsigned char* lds, const int b, const int h) {
    const int tid = fresh_tid(), dg = tid & 63, kq = tid >> 6;
    LAS float* qs = (LAS float*)lds; LAS float* ks = qs + 1024; LAS float* red = ks + 1024; LAS float* rden = red + 16384; LAS float* gsm = rden + 64;
    const int row0 = NROWS_P + b * 8;
    f32x4 C[16];
    { const float* C0 = p.st_C + (((size_t)b * 4 + h) * 128 + kq * 16) * 256 + dg * 4;
#pragma unroll
      for (int i = 0; i < 16; ++i) C[i] = *(const f32x4*)(C0 + i * 256); }
    float nn[16];
#pragma unroll
    for (int i = 0; i < 16; ++i) nn[i] = (dg == 0) ? p.st_n[((size_t)b * 4 + h) * 128 + kq * 16 + i] : 0.f;
    u32x2 vv[8];
    { bf16_t* v = (bf16_t*)(p.ws + WS_U0) + (size_t)row0 * 1024 + h * 256 + dg * 4;
#pragma unroll
      for (int t = 0; t < 8; ++t) vv[t] = *(const u32x2*)(v + t * 1024); }
    { const int t = tid >> 6, c = (tid & 63) * 2;
      const unsigned wq = *(const unsigned*)((const bf16_t*)((unsigned char*)p.out + YS_Q) + (size_t)(row0 + t) * 512 + h * 128 + c);
      const unsigned wk = *(const unsigned*)((const bf16_t*)((unsigned char*)p.out + YS_K) + (size_t)(row0 + t) * 512 + h * 128 + c);
      qs[t * 128 + c] = bflo(wq) * 0.08838834764831845f; qs[t * 128 + c + 1] = bfhi(wq) * 0.08838834764831845f; ks[t * 128 + c] = bflo(wk); ks[t * 128 + c + 1] = bfhi(wk); }
    if (tid == 0) { const float* g = (const float*)(p.ws + WS_GATES) + (size_t)row0 * 8; float m = p.st_m[b * 4 + h];
        for (int t = 0; t < 8; ++t) { const float ig = g[t * 8 + h], lf = g[t * 8 + 4 + h], mn = fmaxf(lf + m, ig);
            gsm[t] = __expf(lf + m - mn); gsm[8 + t] = __expf(ig - mn); gsm[16 + t] = mn; m = mn; } }
    __syncthreads();
#pragma unroll 1
    for (int t = 0; t < 8; ++t) {
        const float fg = gsm[t], ii = gsm[8 + t]; const f32x4 v4 = bf4_to_f32(vv[t]);
        f32x4 part = (f32x4){0.f, 0.f, 0.f, 0.f}; float pden = 0.f;
#pragma unroll
        for (int i = 0; i < 16; ++i) { const float kk = ks[t * 128 + kq * 16 + i] * ii, qv = qs[t * 128 + kq * 16 + i];
            C[i] = C[i] * fg + v4 * kk; part += C[i] * qv; nn[i] = nn[i] * fg + kk; pden += qv * nn[i]; }
        *(LAS f32x4*)(red + (kq * 8 + t) * 256 + dg * 4) = part;
        if (dg == 0) rden[kq * 8 + t] = pden;
    }
    __syncthreads();
    { const int t = tid >> 6; f32x4 sum = (f32x4){0.f, 0.f, 0.f, 0.f};
#pragma unroll
      for (int q = 0; q < 8; ++q) sum += *(const LAS f32x4*)(red + (q * 8 + t) * 256 + dg * 4);
      u32x2 w; w.x = cvt_pk_bf16(sum[0], sum[1]); w.y = cvt_pk_bf16(sum[2], sum[3]);
      *(u32x2*)((bf16_t*)(p.ws + WS_U0) + (size_t)(row0 + t) * 1024 + h * 256 + dg * 4) = w; }
    if (tid < 8) { float d = 0.f;
#pragma unroll
        for (int q = 0; q < 8; ++q) d += rden[q * 8 + tid];
        ((float*)(p.ws + WS_DEN))[(size_t)(row0 + tid) * 4 + h] = d; ((float*)(p.ws + WS_MT))[(size_t)(row0 + tid) * 4 + h] = gsm[16 + tid]; }
    { float* Co = p.out + O_SC + (((size_t)b * 4 + h) * 128 + kq * 16) * 256 + dg * 4;
#pragma unroll
      for (int i = 0; i < 16; ++i) *(f32x4*)(Co + i * 256) = C[i]; }
    if (dg == 0) {
#pragma unroll
        for (int i = 0; i < 16; ++i) p.out[O_SN + ((size_t)b * 4 + h) * 128 + kq * 16 + i] = nn[i]; }
    if (tid == 0) p.out[O_SM + b * 4 + h] = gsm[23];
    __syncthreads();
}
__device__ __forceinline__ void sample_hgrn(const Params& p, LAS unsigned char* lds, const int b, const int h) {
    const int tid = fresh_tid(), dg = tid & 31, kq = tid >> 5;
    LAS float* fs = (LAS float*)lds; LAS float* kks = fs + 1024; LAS float* qss = kks + 1024; LAS float* red = qss + 1024;
    const int row0 = NROWS_P + b * 8;
    f32x4 S[8];
    { const float* S0 = p.st_S + (((size_t)b * 8 + h) * 128 + kq * 8) * 128 + dg * 4;
#pragma unroll
      for (int i = 0; i < 8; ++i) S[i] = *(const f32x4*)(S0 + i * 128); }
    u32x2 vv[8];
    { const bf16_t* v = (const bf16_t*)(p.ws + WS_U0 + 5 * UB) + (size_t)row0 * 1024 + h * 128 + dg * 4;
#pragma unroll
      for (int t = 0; t < 8; ++t) vv[t] = *(const u32x2*)(v + t * 1024); }
    { const int t = tid >> 6, c = (tid & 63) * 2;
      const unsigned wf = *(const unsigned*)((const bf16_t*)(p.ws + WS_U0 + 3 * UB) + (size_t)(row0 + t) * 1024 + h * 128 + c);
      const unsigned wq = *(const unsigned*)((const bf16_t*)(p.ws + WS_U0 + 4 * UB) + (size_t)(row0 + t) * 1024 + h * 128 + c);
#pragma unroll
      for (int e = 0; e < 2; ++e) { const float fl = e ? bfhi(wf) : bflo(wf), qr = e ? bfhi(wq) : bflo(wq);
          const float p0 = p.lb_param[h * 128 + c + e], p1 = p.lb_param[1024 + h * 128 + c + e], lb = __frcp_rn(1.0f + __expf(p1 - p0)), sg = sigmoidf_(fl);
          fs[t * 128 + c + e] = lb + (1.0f - lb) * sg; kks[t * 128 + c + e] = (1.0f - lb) * (1.0f - sg); qss[t * 128 + c + e] = qr * sigmoidf_(qr); } }
    __syncthreads();
#pragma unroll 1
    for (int t = 0; t < 8; ++t) {
        const f32x4 v4 = bf4_to_f32(vv[t]); f32x4 part = (f32x4){0.f, 0.f, 0.f, 0.f};
#pragma unroll
        for (int i = 0; i < 8; ++i) { const int dk = t * 128 + kq * 8 + i; S[i] = S[i] * fs[dk] + v4 * kks[dk]; part += S[i] * qss[dk]; }
        *(LAS f32x4*)(red + (kq * 8 + t) * 128 + dg * 4) = part;
    }
    __syncthreads();
    if (tid < 256) { const int t = tid >> 5; f32x4 sum = (f32x4){0.f, 0.f, 0.f, 0.f};
#pragma unroll
      for (int q = 0; q < 16; ++q) sum += *(const LAS f32x4*)(red + (q * 8 + t) * 128 + dg * 4);
      u32x2 w; w.x = cvt_pk_bf16(sum[0], sum[1]); w.y = cvt_pk_bf16(sum[2], sum[3]);
      *(u32x2*)((bf16_t*)(p.ws + WS_U0 + 5 * UB) + (size_t)(row0 + t) * 1024 + h * 128 + dg * 4) = w; }
    { float* So = p.out + O_SS + (((size_t)b * 8 + h) * 128 + kq * 8) * 128 + dg * 4;
#pragma unroll
      for (int i = 0; i < 8; ++i) *(f32x4*)(So + i * 128) = S[i]; }
    __syncthreads();
}

__device__ __forceinline__ void phase_scan(const Params& p, LAS unsigned char* lds) {
    for (int it = blockIdx.x; it < 256; it += gridDim.x) {
        if (it < 128) scan_item<3, true>(p, lds, it >> 4, (it >> 2) & 3, it & 3);
        else { const int i = it - 128; scan_item<2, false>(p, lds, i >> 4, (i >> 1) & 7, i & 1); }
    }
    for (int it = blockIdx.x; it < 1536; it += gridDim.x) {
        if (it < 512) sample_mlstm(p, lds, it >> 2, it & 3);
        else { const int i = it - 512; sample_hgrn(p, lds, i >> 3, i & 7); }
    }
}

template <int PH> __device__ __forceinline__ void run_phase(const Params& p, LAS unsigned char* lds) {
    if constexpr (PH == 0) phase_prep(p, lds);
    if constexpr (PH == 1) {
        pg8::TileOrder S; S.init(NROWS, 7168, 1024, 1024, gridDim.x, blockIdx.x, (unsigned char*)p.out + YS_XN, (unsigned char*)p.out + YS_WIN);
        pg8::EpiProj E{p.ws, p.lb_param};
        pg8::gemm_phase(lds, 1024, 1024, S, E);
    }
    if constexpr (PH == 2) phase_conv(p);
    if constexpr (PH == 3) {
        { pg8::QkvOrder<0> S{(int)gridDim.x, (int)blockIdx.x, (const char*)p.out + YS_XC, (const char*)p.ws + WS_WQK};
          pg8::EpiQkv<0> E{(bf16_t*)((unsigned char*)p.out + YS_Q)};
          pg8::gemm_phase(lds, 256, 1024, S, E); }
        { pg8::QkvOrder<1> S{(int)gridDim.x, (int)blockIdx.x, (const char*)p.ws + WS_U0, (const char*)p.ws + WS_WV};
          pg8::EpiQkv<1> E{(bf16_t*)(p.ws + WS_U0)};
          pg8::gemm_phase(lds, 256, 1024, S, E); }
    }
    if constexpr (PH == 4) phase_gates(p, lds);
    if constexpr (PH == 5) phase_scan(p, lds);
    if constexpr (PH == 6) phase_post(p);
    if constexpr (PH == 7) {
        pg8::TileOrder S; S.init(NROWS_P, 1024, 2048, 2048, gridDim.x, blockIdx.x, p.ws + WS_U0 + 3 * UB, p.ws + WS_WOUT);
        pg8::EpiOut E{p.out + O_Y, p.x_prompt};
        pg8::gemm_phase(lds, 2048, 2048, S, E);
    }
    if constexpr (PH == 8) {
        if (blockIdx.x < 64) {
            pg8::TailOrder S{(int)blockIdx.x, (const char*)p.ws + WS_U0 + 3 * UB + (size_t)NROWS_P * 2048 * 2, (const char*)p.ws + WS_WOUT};
            pg8::EpiPart E{(float*)(p.ws + WS_U0)};
            pg8::gemm_phase(lds, 512, 2048, S, E, 2048);
        } else phase_final<false>(p, 0, NROWS_P, 64, (int)gridDim.x - 64);
    }
    if constexpr (PH == 9) phase_final<true>(p, NROWS_P, NROWS, 0, (int)gridDim.x);
}

#define XB_XCNT(j)  (64 * (j))
#define XB_XSUB(j)  (1024 + 64 * (j))
#define XB_XGEN(j)  (2048 + 64 * (j))
#define XB_TOP      3072
#define XB_TOPGEN   3136
#define XB_WORDS    3200
__device__ __forceinline__ unsigned xb_ld(unsigned* p) { return __hip_atomic_load(p, __ATOMIC_RELAXED, __HIP_MEMORY_SCOPE_AGENT); }
__device__ __forceinline__ unsigned xb_add(unsigned* p, unsigned v) { return __hip_atomic_fetch_add(p, v, __ATOMIC_RELAXED, __HIP_MEMORY_SCOPE_AGENT); }
__device__ __forceinline__ unsigned xb_xcc_id() { return (unsigned)__builtin_amdgcn_s_getreg((3 << 11) | 20) & 0xFu; }
#define XB_SPIN(cond) do { unsigned _sp = 0; while (cond) { __builtin_amdgcn_s_sleep(1); if (++_sp > (1u << 22)) break; } } while (0)
__device__ __forceinline__ void grid_barrier(unsigned* bar, volatile LAS unsigned* st) {
    asm volatile("s_waitcnt vmcnt(0)" ::: "memory");
    __syncthreads();
    if (threadIdx.x == 0) {
        __builtin_amdgcn_s_waitcnt(0);
        const unsigned x = st[0]; unsigned nloc = st[1], nx = st[2];
        if (nloc == 0u) {
            const unsigned G = gridDim.x; unsigned sum, cnt, mine, sp = 0u;
            for (;;) { sum = 0u; cnt = 0u; mine = 0u;
                for (unsigned j = 0; j < 16; ++j) { const unsigned c = xb_ld(&bar[XB_XCNT(j)]); sum += c; cnt += (c > 0u) ? 1u : 0u; mine = (j == x) ? c : mine; }
                if (sum == G || ++sp > (1u << 22)) break;
                __builtin_amdgcn_s_sleep(1); }
            nloc = mine > 0u ? mine : 1u; nx = cnt > 0u ? cnt : 1u; st[1] = nloc; st[2] = nx; }
        const unsigned old = xb_add(&bar[XB_XSUB(x)], 1u), gen = old / nloc;
        if (old + 1u == (gen + 1u) * nloc) {
            __builtin_amdgcn_fence(__ATOMIC_RELEASE, "agent");
            asm volatile("s_waitcnt vmcnt(0)" ::: "memory");
            const unsigned og = xb_add(&bar[XB_TOP], 1u), tg = og / nx;
            if (og + 1u == (tg + 1u) * nx) xb_add(&bar[XB_TOPGEN], 1u);
            else XB_SPIN(xb_ld(&bar[XB_TOPGEN]) == tg);
            __builtin_amdgcn_fence(__ATOMIC_ACQUIRE, "agent");
            xb_add(&bar[XB_XGEN(x)], 1u);
            asm volatile("s_waitcnt vmcnt(0)" ::: "memory");
        } else {
            XB_SPIN(xb_ld(&bar[XB_XGEN(x)]) == gen);
            __builtin_amdgcn_fence(__ATOMIC_ACQUIRE, "agent");
            asm volatile("s_waitcnt vmcnt(0)" ::: "memory");
        }
    }
    __syncthreads();
}
#ifndef MK_ONE
#define MK_ONE 1
#endif
#if MK_ONE
__global__ void __launch_bounds__(512, 2) fwd_megakernel(Params p) {
    extern __shared__ __attribute__((aligned(16))) unsigned char smem[];
    LAS unsigned char* lds = (LAS unsigned char*)smem;
    cg::grid_group grid = cg::this_grid();
    unsigned* bar = (unsigned*)(p.ws + WS_END);
    volatile LAS unsigned* st = (volatile LAS unsigned*)(lds + LDS_BYTES - 16);
    if (threadIdx.x == 0) { const unsigned x = xb_xcc_id(); st[0] = x; st[1] = 0u; (void)xb_add(&bar[XB_XCNT(x)], 1u); }
    run_phase<0>(p, lds); grid_barrier(bar, st);
    run_phase<1>(p, lds); grid.sync();
    run_phase<2>(p, lds); grid_barrier(bar, st);
    run_phase<3>(p, lds); grid_barrier(bar, st);
    run_phase<4>(p, lds); grid_barrier(bar, st);
    run_phase<5>(p, lds); grid_barrier(bar, st);
    run_phase<6>(p, lds); grid_barrier(bar, st);
    run_phase<7>(p, lds); grid_barrier(bar, st);
    run_phase<8>(p, lds); grid_barrier(bar, st);
    run_phase<9>(p, lds);
}
#else
template <int PH> __global__ void __launch_bounds__(512, 2) phase_kernel(Params p) {
    extern __shared__ __attribute__((aligned(16))) unsigned char smem[];
    run_phase<PH>(p, (LAS unsigned char*)smem);
}
template <int PH> static void launch_phase(const Params& p, int grid, hipStream_t stream) {
    static bool attr = false;
    if (!attr) { (void)hipFuncSetAttribute((const void*)phase_kernel<PH>, hipFuncAttributeMaxDynamicSharedMemorySize, LDS_BYTES); attr = true; }
    hipLaunchKernelGGL(phase_kernel<PH>, dim3(grid), dim3(512), LDS_BYTES, stream, p);
}
#endif

extern "C" void kernel_launch(void* const* d_in, const int* in_sizes, int n_in, void* d_out, int out_size, void* d_ws, size_t ws_size, hipStream_t stream) {
    static int grid_blocks = 0;
    if (grid_blocks == 0) {
        if (n_in != 22 || ws_size < WS_END + 12800) { fprintf(stderr, "kernel_launch: unexpected n_in %d / ws_size %zu\n", n_in, ws_size); grid_blocks = -1; return; }
        int dev = 0, cus = 0;
        (void)hipGetDevice(&dev);
        (void)hipDeviceGetAttribute(&cus, hipDeviceAttributeMultiprocessorCount, dev);
#if MK_ONE
        int per_cu = 0;
        if (hipFuncSetAttribute((const void*)fwd_megakernel, hipFuncAttributeMaxDynamicSharedMemorySize, LDS_BYTES) != hipSuccess) { fprintf(stderr, "kernel_launch: hipFuncSetAttribute failed\n"); grid_blocks = -1; return; }
        (void)hipOccupancyMaxActiveBlocksPerMultiprocessor(&per_cu, (const void*)fwd_megakernel, 512, LDS_BYTES);
        if (per_cu < 1) per_cu = 1;
        grid_blocks = cus * per_cu;
#else
        grid_blocks = cus;
#endif
    }
    if (grid_blocks < 0) return;
    Params p{};
    const float** f = (const float**)&p;
    for (int i = 0; i < 22; ++i) f[i] = (const float*)d_in[i];
    p.out = (float*)d_out; p.ws = (unsigned char*)d_ws;
#if MK_ONE
    (void)hipMemsetAsync((unsigned char*)d_ws + WS_END, 0, 12800, stream);
    void* args[] = {&p};
    hipError_t e = hipLaunchCooperativeKernel((const void*)fwd_megakernel, dim3(grid_blocks), dim3(512), args, LDS_BYTES, stream);
    if (e != hipSuccess) fprintf(stderr, "cooperative launch failed: %s (grid %d)\n", hipGetErrorString(e), grid_blocks);
#else
    launch_phase<0>(p, grid_blocks, stream); launch_phase<1>(p, grid_blocks, stream); launch_phase<2>(p, grid_blocks, stream);
    launch_phase<3>(p, grid_blocks, stream); launch_phase<4>(p, grid_blocks, stream); launch_phase<5>(p, grid_blocks, stream);
    launch_phase<6>(p, grid_blocks, stream); launch_phase<7>(p, grid_blocks, stream); launch_phase<8>(p, grid_blocks, stream); launch_phase<9>(p, grid_blocks, stream);
#endif
}
```

```cpp
#include <hip/hip_runtime.h>
#include <hip/hip_cooperative_groups.h>
#include <cstdio>
namespace cg = cooperative_groups;

typedef unsigned short bf16_t;
typedef short bf16x8 __attribute__((ext_vector_type(8)));
typedef float f32x4 __attribute__((ext_vector_type(4)));
typedef float f32x16 __attribute__((ext_vector_type(16)));
typedef unsigned u32x4 __attribute__((ext_vector_type(4)));
typedef unsigned u32x2 __attribute__((ext_vector_type(2)));
#define LAS __attribute__((address_space(3)))

constexpr int NROWS_P = 16384, NROWS = 17408, DM = 1024;
constexpr size_t UB = (size_t)NROWS * 1024 * 2;
constexpr size_t WS_U0 = 0;
constexpr size_t WS_WOUT = 7 * UB;
constexpr size_t WS_WQK = WS_WOUT + 4194304;
constexpr size_t WS_WV = WS_WQK + 524288;
constexpr size_t WS_GATES = WS_WV + 524288;
constexpr size_t WS_DEN = WS_GATES + (size_t)NROWS * 32;
constexpr size_t WS_MT = WS_DEN + (size_t)NROWS * 16;
constexpr size_t WS_END = WS_MT + (size_t)NROWS * 16;
constexpr size_t YS_XN = 0, YS_WIN = UB, YS_XC = 0, YS_Q = UB, YS_K = UB + UB / 2;
constexpr size_t O_Y = 0, O_PCONV = 17825792, O_PC = 17850368, O_PN = 18898944, O_PM = 18903040, O_PS = 18903072,
                 O_SCONV = 19951648, O_SC = 20344864, O_SN = 37122080, O_SM = 37187616, O_SS = 37188128;

constexpr int LDS_BYTES = 158224;

struct Params {
    const float* x_prompt; const float* x_sample; const float* st_conv; const float* st_C; const float* st_n; const float* st_m; const float* st_S;
    const float* g_norm; const float* w_in; const float* conv_w; const float* conv_b; const float* w_q; const float* w_k; const float* w_v;
    const float* w_gate; const float* b_gate; const float* m_ln; const float* m_skip; const float* lb_param; const float* h_norm; const float* w_out; const float* g_final;
    float* out; unsigned char* ws;
};

typedef __bf16 bf16v2 __attribute__((ext_vector_type(2)));
typedef float f32x2 __attribute__((ext_vector_type(2)));
__device__ __forceinline__ unsigned cvt_pk_bf16(float lo, float hi) { const f32x2 v = {lo, hi}; const bf16v2 r = __builtin_convertvector(v, bf16v2); return __builtin_bit_cast(unsigned, r); }
__device__ __forceinline__ bf16_t f2bf(float f) { return (bf16_t)(cvt_pk_bf16(f, 0.f) & 0xffffu); }
__device__ __forceinline__ float bf2f(bf16_t v) { return __uint_as_float(((unsigned)v) << 16); }
__device__ __forceinline__ float bflo(unsigned w) { return __uint_as_float(w << 16); }
__device__ __forceinline__ float bfhi(unsigned w) { return __uint_as_float(w & 0xffff0000u); }
__device__ __forceinline__ int fresh_tid() { int t = threadIdx.x; asm volatile("" : "+v"(t)); return t; }
__device__ __forceinline__ float sigmoidf_(float x) { return __frcp_rn(1.0f + __expf(-x)); }
__device__ __forceinline__ void unpack8(const u32x4 v, float* f) { f[0] = bflo(v.x); f[1] = bfhi(v.x); f[2] = bflo(v.y); f[3] = bfhi(v.y); f[4] = bflo(v.z); f[5] = bfhi(v.z); f[6] = bflo(v.w); f[7] = bfhi(v.w); }
__device__ __forceinline__ u32x4 pack8(const float* f) { u32x4 w; w.x = cvt_pk_bf16(f[0], f[1]); w.y = cvt_pk_bf16(f[2], f[3]); w.z = cvt_pk_bf16(f[4], f[5]); w.w = cvt_pk_bf16(f[6], f[7]); return w; }

namespace pg8 {
constexpr int BM = 256, BK = 64, HALF = 128, HTB = HALF * BK * 2, STAGE_BYTES = 8 * HTB, NXCD = 8, WGM = 8;
__host__ __device__ __forceinline__ int lds_byte(int r, int c) { const int st = (r >> 4) * 2 + (c >> 5), rr = r & 15, cc = c & 31, ob = rr * 64 + cc * 2; return st * 1024 + (ob ^ (((ob >> 9) & 1) << 5)); }
__host__ __device__ __forceinline__ void stage_rc(int b, int& R, int& C) { const int st = b / 1024, sb = b % 1024, swz = sb ^ (((sb >> 9) & 1) << 5); R = (st >> 1) * 16 + swz / 64; C = (st & 1) * 32 + (swz % 64) / 2; }
__host__ __device__ __forceinline__ int perm32(int rho) { const int n = rho >> 4, i = rho & 15; return 8 * (i >> 2) + 4 * n + (i & 3); }

struct Unit { int pm, pn; const char* a; const char* b; };

template <class Epi, class Sched>
__device__ __forceinline__ void gemm_phase(LAS unsigned char* lds, const int K, const int lda, const Sched& S, const Epi& E, const int ldb_ = 0) {
    const int tid = fresh_tid(), wid = __builtin_amdgcn_readfirstlane(tid >> 6), lane = tid & 63, wr = wid >> 2, wc = wid & 3, fr = lane & 15, fq = lane >> 4;
    const int nt = K / BK;
    unsigned voffA[2], voffB[2];
#pragma unroll
    for (int i = 0; i < 2; ++i) { int R, C; stage_rc(tid * 16 + i * 8192, R, C); const int Rb = Epi::PERM ? ((R & ~31) + perm32(R & 31)) : R;
        voffA[i] = (unsigned)(R * lda + C) * 2u; voffB[i] = (unsigned)(Rb * (ldb_ ? ldb_ : K) + C) * 2u; }
    const size_t kstep = (size_t)(BK * 2);
    const size_t hstepA = (size_t)HALF * lda * 2, hstepB = (size_t)HALF * (ldb_ ? ldb_ : K) * 2;
    const unsigned ldsw = (unsigned)wid * 1024u;
    const int aoff = lds_byte(wr * 64 + fr, fq * 8), boff = lds_byte(wc * 32 + fr, fq * 8);
#define PG8_SA(b, h) (((b) * 2 + (h)) * HTB)
#define PG8_SB(b, h) ((4 + (b) * 2 + (h)) * HTB)
#define PG8_STAGE(bufoff, gbase, voff) do { _Pragma("unroll") for (int _i = 0; _i < 2; ++_i) \
        __builtin_amdgcn_global_load_lds((const unsigned*)((const char*)(gbase) + (voff)[_i]), (LAS unsigned*)(lds + (bufoff) + ldsw + _i * 8192), 16, 0, 0); } while (0)
#define PG8_LDA(dst, b, h) do { _Pragma("unroll") for (int m = 0; m < 4; ++m) _Pragma("unroll") for (int k = 0; k < 2; ++k) dst[m][k] = *(const LAS bf16x8*)(lds + PG8_SA(b, h) + aoff + m * 2048 + k * 1024); } while (0)
#define PG8_LDB(dst, b, h) do { _Pragma("unroll") for (int n = 0; n < 2; ++n) _Pragma("unroll") for (int k = 0; k < 2; ++k) dst[n][k] = *(const LAS bf16x8*)(lds + PG8_SB(b, h) + boff + n * 2048 + k * 1024); } while (0)
#define PG8_MMA(ai, bj, At, Bt) do { __builtin_amdgcn_s_setprio(1); _Pragma("unroll") for (int m = 0; m < 4; ++m) _Pragma("unroll") for (int n = 0; n < 2; ++n) _Pragma("unroll") for (int k = 0; k < 2; ++k) \
        acc[ai][bj][m][n] = __builtin_amdgcn_mfma_f32_16x16x32_bf16(Bt[n][k], At[m][k], acc[ai][bj][m][n], 0, 0, 0); __builtin_amdgcn_s_setprio(0); } while (0)
#define PG8_WAIT_V(n) asm volatile("s_waitcnt vmcnt(" #n ")" ::: "memory")
#define PG8_WAIT_L(n) asm volatile("s_waitcnt lgkmcnt(" #n ")" ::: "memory")
#define PG8_BAR __builtin_amdgcn_s_barrier()
#define PG8_SCHED __builtin_amdgcn_sched_barrier(0)
    Unit cur, nxt; int ui = 0;
    if (!S.next(0, cur)) return;
    f32x4 acc[2][2][4][2];
#pragma unroll
    for (int a = 0; a < 2; ++a)
#pragma unroll
        for (int b = 0; b < 2; ++b)
#pragma unroll
            for (int m = 0; m < 4; ++m)
#pragma unroll
                for (int n = 0; n < 2; ++n) acc[a][b][m][n] = (f32x4){0.f, 0.f, 0.f, 0.f};
    bf16x8 At[4][2], B0[2][2], B1[2][2];
    const char* cA = cur.a; const char* cB = cur.b;
    PG8_STAGE(PG8_SB(0, 0), cB, voffB); PG8_STAGE(PG8_SB(0, 1), cB + hstepB, voffB); PG8_STAGE(PG8_SA(0, 0), cA, voffA); PG8_STAGE(PG8_SA(0, 1), cA + hstepA, voffA);
    if (wr == 1) PG8_BAR;
    PG8_WAIT_V(2); PG8_BAR;
    PG8_STAGE(PG8_SB(1, 0), cB + kstep, voffB); PG8_STAGE(PG8_SA(1, 0), cA + kstep, voffA); PG8_STAGE(PG8_SB(1, 1), cB + hstepB + kstep, voffB);
    PG8_WAIT_V(6); PG8_BAR;
    for (;;) {
        const bool has_next = S.next(ui + 1, nxt);
        const char* nA = has_next ? nxt.a : cA; const char* nB = has_next ? nxt.b : cB;
        for (int t = 0; t < nt; t += 2) {
            const bool last = (t == nt - 2);
            const char* a1 = cA + (size_t)(t + 1) * kstep;
            const char* a2 = last ? nA : cA + (size_t)(t + 2) * kstep; const char* b2 = last ? nB : cB + (size_t)(t + 2) * kstep;
            const char* a3 = a2 + kstep; const char* b3 = b2 + kstep;
            PG8_LDB(B0, 0, 0); PG8_LDB(B1, 0, 1); PG8_SCHED; PG8_LDA(At, 0, 0); PG8_STAGE(PG8_SA(1, 1), a1 + hstepA, voffA);
            PG8_WAIT_V(8); PG8_WAIT_L(0); PG8_BAR; PG8_MMA(0, 0, At, B0); PG8_MMA(0, 1, At, B1); PG8_BAR; PG8_SCHED;
            PG8_LDA(At, 0, 1); PG8_STAGE(PG8_SB(0, 0), b2, voffB); PG8_STAGE(PG8_SB(0, 1), b2 + hstepB, voffB); PG8_STAGE(PG8_SA(0, 0), a2, voffA);
            PG8_WAIT_V(8); PG8_WAIT_L(0); PG8_BAR; PG8_MMA(1, 0, At, B0); PG8_MMA(1, 1, At, B1); PG8_BAR; PG8_SCHED;
            PG8_LDB(B0, 1, 0); PG8_LDB(B1, 1, 1); PG8_SCHED; PG8_LDA(At, 1, 0); PG8_STAGE(PG8_SA(0, 1), a2 + hstepA, voffA);
            PG8_WAIT_V(8); PG8_WAIT_L(0); PG8_BAR; PG8_MMA(0, 0, At, B0); PG8_MMA(0, 1, At, B1); PG8_BAR; PG8_SCHED;
            PG8_LDA(At, 1, 1); PG8_STAGE(PG8_SB(1, 0), b3, voffB); PG8_STAGE(PG8_SB(1, 1), b3 + hstepB, voffB); PG8_STAGE(PG8_SA(1, 0), a3, voffA);
            PG8_WAIT_V(8); PG8_WAIT_L(0); PG8_BAR; PG8_MMA(1, 0, At, B0); PG8_MMA(1, 1, At, B1); PG8_BAR; PG8_SCHED;
        }
        E(acc, cur, wr, wc, fr, fq);
        if (!has_next) break;
#pragma unroll
        for (int a = 0; a < 2; ++a)
#pragma unroll
            for (int b = 0; b < 2; ++b)
#pragma unroll
                for (int m = 0; m < 4; ++m)
#pragma unroll
                    for (int n = 0; n < 2; ++n) acc[a][b][m][n] = (f32x4){0.f, 0.f, 0.f, 0.f};
        cur = nxt; cA = nA; cB = nB; ++ui;
    }
    PG8_WAIT_V(0);
    if (wr == 0) PG8_BAR;
    PG8_BAR;
#undef PG8_SA
#undef PG8_SB
#undef PG8_STAGE
#undef PG8_LDA
#undef PG8_LDB
#undef PG8_MMA
#undef PG8_WAIT_V
#undef PG8_WAIT_L
#undef PG8_BAR
#undef PG8_SCHED
}

struct TileOrder {
    int nM, nN, nwg, G, c; const char* A; const char* Bt; size_t tA, tB;
    __device__ void init(int M, int N, int K, int lda, int G_, int c_, const void* A_, const void* Bt_) { nM = M / BM; nN = N / BM; nwg = nM * nN; G = G_; c = c_; A = (const char*)A_; Bt = (const char*)Bt_; tA = (size_t)BM * lda * 2; tB = (size_t)BM * K * 2; }
    __device__ bool next(int i, Unit& u) const {
        const long L = (long)i * G + c; if (L >= nwg) return false;
        int wgid = (int)L; { const int q = nwg / NXCD, r = nwg % NXCD, xcd = wgid % NXCD, off = wgid / NXCD; wgid = (xcd < r ? xcd * (q + 1) : r * (q + 1) + (xcd - r) * q) + off; }
        const int nig = WGM * nN, gid = wgid / nig, fm = gid * WGM, gsz = (nM - fm) < WGM ? (nM - fm) : WGM;
        u.pm = fm + ((wgid % nig) % gsz); u.pn = (wgid % nig) / gsz; u.a = A + (size_t)u.pm * tA; u.b = Bt + (size_t)u.pn * tB; return true;
    }
};
template <int TYPE> struct QkvOrder {
    int G, c; const char* A; const char* W;
    __device__ bool next(int i, Unit& u) const {
        const int L = i * G + c; if (L >= 68 * 4) return false;
        u.pm = L >> 2; u.pn = L & 3;
        u.a = A + ((size_t)u.pm * 256 * 1024 + u.pn * 256) * 2; u.b = W + (size_t)u.pn * 256 * 256 * 2; return true;
    }
};

struct EpiProj {
    static constexpr bool PERM = true;
    unsigned char* ws; const float* lbp;
    __device__ __forceinline__ void operator()(const f32x4 (&acc)[2][2][4][2], const Unit& u, int wr, int wc, int fr, int fq) const {
        const int ub = u.pn >> 2;
        bf16_t* base = (bf16_t*)(ws + (size_t)ub * UB);
        const int row0 = u.pm * BM + wr * 64 + fr, col0 = (u.pn & 3) * 256 + wc * 32 + 8 * fq;
        const int mode = (u.pm < 64) ? (ub == 3 ? 1 : (ub == 4 ? 2 : 0)) : 0;
        float lb[2][8];
        if (mode == 1) {
#pragma unroll
            for (int bj = 0; bj < 2; ++bj)
#pragma unroll
                for (int e = 0; e < 8; ++e) { const int c = col0 + bj * HALF + e; lb[bj][e] = __frcp_rn(1.0f + __expf(lbp[1024 + c] - lbp[c])); }
        }
#pragma unroll
        for (int ai = 0; ai < 2; ++ai)
#pragma unroll
            for (int m = 0; m < 4; ++m) { bf16_t* rowp = base + (size_t)(row0 + ai * HALF + m * 16) * 1024 + col0;
#pragma unroll
                for (int bj = 0; bj < 2; ++bj) { float v[8];
#pragma unroll
                    for (int e = 0; e < 4; ++e) { v[e] = acc[ai][bj][m][0][e]; v[4 + e] = acc[ai][bj][m][1][e]; }
                    if (mode == 1) {
#pragma unroll
                        for (int e = 0; e < 8; ++e) v[e] = __builtin_amdgcn_logf(lb[bj][e] + (1.0f - lb[bj][e]) * sigmoidf_(v[e]));
                    } else if (mode == 2) {
#pragma unroll
                        for (int e = 0; e < 8; ++e) v[e] = v[e] * sigmoidf_(v[e]);
                    }
                    *(u32x4*)(rowp + bj * HALF) = pack8(v); } }
    }
};
template <int TYPE> struct EpiQkv {
    static constexpr bool PERM = true;
    bf16_t* o;
    __device__ __forceinline__ void operator()(const f32x4 (&acc)[2][2][4][2], const Unit& u, int wr, int wc, int fr, int fq) const {
        constexpr int ld = TYPE ? 1024 : 512; constexpr size_t bjoff = TYPE ? 128 : (UB / 4);
        bf16_t* base = o + u.pn * (TYPE ? 256 : 128) + (size_t)(u.pm * BM + wr * 64 + fr) * ld + wc * 32 + 8 * fq;
#pragma unroll
        for (int ai = 0; ai < 2; ++ai)
#pragma unroll
            for (int m = 0; m < 4; ++m) { bf16_t* rowp = base + (size_t)(ai * HALF + m * 16) * ld;
#pragma unroll
                for (int bj = 0; bj < 2; ++bj) { const f32x4 v0 = acc[ai][bj][m][0], v1 = acc[ai][bj][m][1];
                    u32x4 w; w.x = cvt_pk_bf16(v0[0], v0[1]); w.y = cvt_pk_bf16(v0[2], v0[3]); w.z = cvt_pk_bf16(v1[0], v1[1]); w.w = cvt_pk_bf16(v1[2], v1[3]);
                    *(u32x4*)(rowp + bj * bjoff) = w; } }
    }
};
struct TailOrder {
    int c; const char* A; const char* Bt;
    __device__ bool next(int i, Unit& u) const {
        if (i > 0 || c >= 64) return false;
        const int un = c >> 2, sl = c & 3; u.pm = un & 3; u.pn = (un >> 2) | (sl << 4);
        u.a = A + (size_t)u.pm * 256 * 2048 * 2 + sl * 1024; u.b = Bt + (size_t)(un >> 2) * 256 * 2048 * 2 + sl * 1024; return true;
    }
};
struct EpiPart {
    static constexpr bool PERM = false;
    float* part;
    __device__ __forceinline__ void operator()(const f32x4 (&acc)[2][2][4][2], const Unit& u, int wr, int wc, int fr, int fq) const {
        const int row0 = u.pm * BM + wr * 64 + fr, col0 = (u.pn & 15) * BM + wc * 32 + 4 * fq;
        float* o = part + (size_t)(u.pn >> 4) * 1024 * 1024;
#pragma unroll
        for (int ai = 0; ai < 2; ++ai)
#pragma unroll
            for (int m = 0; m < 4; ++m) { const size_t ro = (size_t)(row0 + ai * HALF + m * 16) * 1024 + col0;
#pragma unroll
                for (int bj = 0; bj < 2; ++bj)
#pragma unroll
                    for (int n = 0; n < 2; ++n) *(f32x4*)(o + ro + bj * HALF + n * 16) = acc[ai][bj][m][n]; }
    }
};
struct EpiOut {
    static constexpr bool PERM = false;
    float* y; const float* x;
    __device__ __forceinline__ void operator()(const f32x4 (&acc)[2][2][4][2], const Unit& u, int wr, int wc, int fr, int fq) const {
        const int row0 = u.pm * BM + wr * 64 + fr, col0 = u.pn * BM + wc * 32 + 4 * fq;
#pragma unroll
        for (int ai = 0; ai < 2; ++ai)
#pragma unroll
            for (int m = 0; m < 4; ++m) { const size_t ro = (size_t)(row0 + ai * HALF + m * 16) * 1024 + col0;
#pragma unroll
                for (int bj = 0; bj < 2; ++bj)
#pragma unroll
                    for (int n = 0; n < 2; ++n) { const f32x4 xv = *(const f32x4*)(x + ro + bj * HALF + n * 16); *(f32x4*)(y + ro + bj * HALF + n * 16) = acc[ai][bj][m][n] + xv; } }
    }
};
}

__device__ __forceinline__ float wave_sum(float v) {
#pragma unroll
    for (int o = 32; o >= 1; o >>= 1) v += __shfl_xor(v, o);
    return v;
}

__device__ __forceinline__ void tr_tile(LAS float* tile, const float* __restrict__ src, int ld_src, bf16_t* __restrict__ dst, int ld_dst, int r0, int c0) {
    const int tid = threadIdx.x;
    { const int tr = tid >> 4, tc = (tid & 15) * 4;
#pragma unroll
      for (int i = 0; i < 2; ++i) { const int r = tr + 32 * i; const f32x4 v = *(const f32x4*)(src + (size_t)(r0 + r) * ld_src + c0 + tc);
          tile[r * 65 + tc] = v[0]; tile[r * 65 + tc + 1] = v[1]; tile[r * 65 + tc + 2] = v[2]; tile[r * 65 + tc + 3] = v[3]; } }
    __syncthreads();
    { const int c = tid >> 3, rg = (tid & 7) * 8; float f[8];
#pragma unroll
      for (int j = 0; j < 8; ++j) f[j] = tile[(rg + j) * 65 + c];
      *(u32x4*)(dst + (size_t)(c0 + c) * ld_dst + r0 + rg) = pack8(f); }
    __syncthreads();
}

__device__ __forceinline__ void phase_prep(const Params& p, LAS unsigned char* lds) {
    LAS float* tile = (LAS float*)lds;
    bf16_t* winT = (bf16_t*)((unsigned char*)p.out + YS_WIN);
    bf16_t* woutT = (bf16_t*)(p.ws + WS_WOUT);
    bf16_t* wqkT = (bf16_t*)(p.ws + WS_WQK);
    bf16_t* wvT = (bf16_t*)(p.ws + WS_WV);
    bf16_t* xn = (bf16_t*)((unsigned char*)p.out + YS_XN);
    constexpr int T_WIN = 16 * 112, T_WOUT = 32 * 16, T_WQ = 32, T_WK = 32, T_WV = 64;
    constexpr int T_ALL = T_WIN + T_WOUT + T_WQ + T_WK + T_WV, XN_GROUPS = NROWS / 8;
    for (int w = blockIdx.x; w < T_ALL + XN_GROUPS; w += gridDim.x) {
        if (w < T_ALL) {
            int t = w;
            if (t < T_WIN) { tr_tile(tile, p.w_in, 7168, winT, 1024, (t & 15) * 64, (t >> 4) * 64); continue; }
            t -= T_WIN;
            if (t < T_WOUT) { tr_tile(tile, p.w_out, 1024, woutT, 2048, (t & 31) * 64, (t >> 5) * 64); continue; }
            t -= T_WOUT;
            if (t < T_WQ) { const int h = t >> 3, tt = t & 7; tr_tile(tile, p.w_q + (size_t)h * 256 * 128, 128, wqkT + (size_t)h * 65536, 256, (tt & 3) * 64, (tt >> 2) * 64); continue; }
            t -= T_WQ;
            if (t < T_WK) { const int h = t >> 3, tt = t & 7; tr_tile(tile, p.w_k + (size_t)h * 256 * 128, 128, wqkT + (size_t)h * 65536 + 128 * 256, 256, (tt & 3) * 64, (tt >> 2) * 64); continue; }
            t -= T_WK;
            { const int h = t >> 4, tt = t & 15; tr_tile(tile, p.w_v + (size_t)h * 65536, 256, wvT + (size_t)h * 65536, 256, (tt & 3) * 64, (tt >> 2) * 64); }
        } else {
            const int r = (w - T_ALL) * 8 + (threadIdx.x >> 6), lane = threadIdx.x & 63;
            const float* src = (r < NROWS_P) ? p.x_prompt + (size_t)r * 1024 : p.x_sample + (size_t)(r - NROWS_P) * 1024;
            f32x4 v[4]; float ss = 0.f;
#pragma unroll
            for (int i = 0; i < 4; ++i) { v[i] = *(const f32x4*)(src + lane * 4 + 256 * i); ss += v[i][0] * v[i][0] + v[i][1] * v[i][1] + v[i][2] * v[i][2] + v[i][3] * v[i][3]; }
            ss = wave_sum(ss);
            const float rstd = rsqrtf(ss * (1.0f / 1024.0f) + 1e-6f);
#pragma unroll
            for (int i = 0; i < 4; ++i) { const f32x4 g = *(const f32x4*)(p.g_norm + lane * 4 + 256 * i);
                u32x2 w; w.x = cvt_pk_bf16(v[i][0] * rstd * g[0], v[i][1] * rstd * g[1]); w.y = cvt_pk_bf16(v[i][2] * rstd * g[2], v[i][3] * rstd * g[3]);
                *(u32x2*)(xn + (size_t)r * 1024 + lane * 4 + 256 * i) = w; }
        }
    }
}

__device__ __forceinline__ void phase_conv(const Params& p) {
    const bf16_t* xm = (const bf16_t*)(p.ws + WS_U0);
    bf16_t* xc = (bf16_t*)((unsigned char*)p.out + YS_XC);
    const int nthreads = gridDim.x * blockDim.x;
    for (int idx = blockIdx.x * blockDim.x + fresh_tid(); idx < NROWS * 128; idx += nthreads) {
        const int r = idx >> 7, c0 = (idx & 127) * 8;
        int b, t; const bool samp = r >= NROWS_P;
        if (!samp) { b = r >> 11; t = r & 2047; } else { b = (r - NROWS_P) >> 3; t = (r - NROWS_P) & 7; }
        float accv[8];
        { const f32x4 b0 = *(const f32x4*)(p.conv_b + c0), b1 = *(const f32x4*)(p.conv_b + c0 + 4);
          accv[0] = b0[0]; accv[1] = b0[1]; accv[2] = b0[2]; accv[3] = b0[3]; accv[4] = b1[0]; accv[5] = b1[1]; accv[6] = b1[2]; accv[7] = b1[3]; }
        float cur[8];
#pragma unroll
        for (int j = 0; j < 4; ++j) {
            const int tt = t - 3 + j; float xv[8];
            if (tt >= 0) { unpack8(*(const u32x4*)(xm + (size_t)(r - 3 + j) * 1024 + c0), xv); }
            else if (samp) { const float* s = p.st_conv + ((size_t)b * 3 + (t + j)) * 1024 + c0; const f32x4 s0 = *(const f32x4*)s, s1 = *(const f32x4*)(s + 4);
                xv[0] = s0[0]; xv[1] = s0[1]; xv[2] = s0[2]; xv[3] = s0[3]; xv[4] = s1[0]; xv[5] = s1[1]; xv[6] = s1[2]; xv[7] = s1[3]; }
            else {
#pragma unroll
                for (int e = 0; e < 8; ++e) xv[e] = 0.f; }
            const f32x4 w0 = *(const f32x4*)(p.conv_w + j * 1024 + c0), w1 = *(const f32x4*)(p.conv_w + j * 1024 + c0 + 4);
            accv[0] += w0[0] * xv[0]; accv[1] += w0[1] * xv[1]; accv[2] += w0[2] * xv[2]; accv[3] += w0[3] * xv[3];
            accv[4] += w1[0] * xv[4]; accv[5] += w1[1] * xv[5]; accv[6] += w1[2] * xv[6]; accv[7] += w1[3] * xv[7];
            if (j == 3) {
#pragma unroll
                for (int e = 0; e < 8; ++e) cur[e] = xv[e]; }
        }
#pragma unroll
        for (int e = 0; e < 8; ++e) accv[e] = accv[e] * sigmoidf_(accv[e]);
        *(u32x4*)(xc + (size_t)r * 1024 + c0) = pack8(accv);
        float* cdst = nullptr;
        if (!samp) { if (t >= 2045) cdst = p.out + O_PCONV + ((size_t)b * 3 + (t - 2045)) * 1024 + c0; }
        else { if (t >= 5) cdst = p.out + O_SCONV + ((size_t)b * 3 + (t - 5)) * 1024 + c0; }
        if (cdst) { *(f32x4*)cdst = (f32x4){cur[0], cur[1], cur[2], cur[3]}; *(f32x4*)(cdst + 4) = (f32x4){cur[4], cur[5], cur[6], cur[7]}; }
    }
}

__device__ __forceinline__ void phase_gates(const Params& p, LAS unsigned char* lds) {
    LAS f32x4* wgA = (LAS f32x4*)lds;
    LAS f32x4* wgB = wgA + 2048;
    for (int i = threadIdx.x; i < 2048; i += blockDim.x) {
        const f32x4 a = *(const f32x4*)(p.w_gate + (size_t)i * 8), b = *(const f32x4*)(p.w_gate + (size_t)i * 8 + 4);
        const int slot = (i & 7) * 256 + (i >> 3); wgA[slot] = a; wgB[slot] = b; }
    __syncthreads();
    const bf16_t* q = (const bf16_t*)((unsigned char*)p.out + YS_Q);
    const bf16_t* k = (const bf16_t*)((unsigned char*)p.out + YS_K);
    const bf16_t* v = (const bf16_t*)(p.ws + WS_U0);
    float* gates = (float*)(p.ws + WS_GATES);
    const int tid = fresh_tid(), lane = tid & 63, wave = blockIdx.x * 8 + (tid >> 6), nw = gridDim.x * 8;
    for (int r = wave; r < NROWS; r += nw) {
        u32x4 d[4];
        d[0] = *(const u32x4*)(q + (size_t)r * 512 + lane * 8); d[1] = *(const u32x4*)(k + (size_t)r * 512 + lane * 8);
        d[2] = *(const u32x4*)(v + (size_t)r * 1024 + lane * 8); d[3] = *(const u32x4*)(v + (size_t)r * 1024 + 512 + lane * 8);
        f32x4 ga = (f32x4){0.f, 0.f, 0.f, 0.f}, gb = ga;
#pragma unroll 1
        for (int c = 0; c < 4; ++c) { float f[8]; unpack8(d[c], f);
#pragma unroll
            for (int j = 0; j < 8; ++j) { const int slot = j * 256 + c * 64 + lane; ga += wgA[slot] * f[j]; gb += wgB[slot] * f[j]; } }
        float g8[8] = {ga[0], ga[1], ga[2], ga[3], gb[0], gb[1], gb[2], gb[3]};
#pragma unroll
        for (int j = 0; j < 8; ++j) g8[j] = wave_sum(g8[j]);
        if (lane < 8) {
            float val = g8[0];
#pragma unroll
            for (int j = 1; j < 8; ++j) val = (lane == j) ? g8[j] : val;
            val += p.b_gate[lane];
            if (lane >= 4) val = fminf(val, 0.f) - __logf(1.0f + __expf(-fabsf(val)));
            gates[(size_t)r * 8 + lane] = val;
        }
    }
    __syncthreads();
}

__device__ __forceinline__ void phase_post(const Params& p) {
    const bf16_t* num = (const bf16_t*)(p.ws + WS_U0);
    const bf16_t* zm = (const bf16_t*)(p.ws + WS_U0 + UB);
    const bf16_t* om = (const bf16_t*)(p.ws + WS_U0 + 2 * UB);
    const bf16_t* oh = (const bf16_t*)(p.ws + WS_U0 + 5 * UB);
    const bf16_t* zh = (const bf16_t*)(p.ws + WS_U0 + 6 * UB);
    const bf16_t* xc = (const bf16_t*)((unsigned char*)p.out + YS_XC);
    bf16_t* mix = (bf16_t*)(p.ws + WS_U0 + 3 * UB);
    const float* den = (const float*)(p.ws + WS_DEN);
    const float* mt = (const float*)(p.ws + WS_MT);
    const int tid = fresh_tid(), lane = tid & 63, wave = blockIdx.x * 8 + (tid >> 6), nw = gridDim.x * 8;
    const int c0 = lane * 16;
    for (int r = wave; r < NROWS; r += nw) {
        {
            const int h = lane >> 4;
            float x[16], t[16];
            unpack8(*(const u32x4*)(num + (size_t)r * 1024 + c0), x); unpack8(*(const u32x4*)(num + (size_t)r * 1024 + c0 + 8), x + 8);
            const float dn = den[(size_t)r * 4 + h], m = mt[(size_t)r * 4 + h];
            const float inv = __frcp_rn(fmaxf(fabsf(dn), __expf(-m)));
            float s = 0.f;
#pragma unroll
            for (int j = 0; j < 16; ++j) { x[j] *= inv; s += x[j]; }
            s += __shfl_xor(s, 1); s += __shfl_xor(s, 2); s += __shfl_xor(s, 4); s += __shfl_xor(s, 8);
            const float mu = s * (1.0f / 256.0f);
            float vs = 0.f;
#pragma unroll
            for (int j = 0; j < 16; ++j) { x[j] -= mu; vs += x[j] * x[j]; }
            vs += __shfl_xor(vs, 1); vs += __shfl_xor(vs, 2); vs += __shfl_xor(vs, 4); vs += __shfl_xor(vs, 8);
            const float rstd = rsqrtf(vs * (1.0f / 256.0f) + 1e-6f);
            unpack8(*(const u32x4*)(om + (size_t)r * 1024 + c0), t); unpack8(*(const u32x4*)(om + (size_t)r * 1024 + c0 + 8), t + 8);
#pragma unroll
            for (int j = 0; j < 16; ++j) x[j] = x[j] * rstd * p.m_ln[c0 + j] * sigmoidf_(t[j]);
            unpack8(*(const u32x4*)(xc + (size_t)r * 1024 + c0), t); unpack8(*(const u32x4*)(xc + (size_t)r * 1024 + c0 + 8), t + 8);
#pragma unroll
            for (int j = 0; j < 16; ++j) x[j] += p.m_skip[c0 + j] * t[j];
            unpack8(*(const u32x4*)(zm + (size_t)r * 1024 + c0), t); unpack8(*(const u32x4*)(zm + (size_t)r * 1024 + c0 + 8), t + 8);
#pragma unroll
            for (int j = 0; j < 16; ++j) x[j] *= t[j] * sigmoidf_(t[j]);
            *(u32x4*)(mix + (size_t)r * 2048 + c0) = pack8(x); *(u32x4*)(mix + (size_t)r * 2048 + c0 + 8) = pack8(x + 8);
        }
        {
            float x[16], t[16];
            unpack8(*(const u32x4*)(oh + (size_t)r * 1024 + c0), x); unpack8(*(const u32x4*)(oh + (size_t)r * 1024 + c0 + 8), x + 8);
            float s = 0.f;
#pragma unroll
            for (int j = 0; j < 16; ++j) s += x[j] * x[j];
            s += __shfl_xor(s, 1); s += __shfl_xor(s, 2); s += __shfl_xor(s, 4);
            const float rstd = rsqrtf(s * (1.0f / 128.0f) + 1e-6f);
            unpack8(*(const u32x4*)(zh + (size_t)r * 1024 + c0), t); unpack8(*(const u32x4*)(zh + (size_t)r * 1024 + c0 + 8), t + 8);
#pragma unroll
            for (int j = 0; j < 16; ++j) x[j] = x[j] * rstd * p.h_norm[c0 + j] * t[j] * sigmoidf_(t[j]);
            *(u32x4*)(mix + (size_t)r * 2048 + 1024 + c0) = pack8(x); *(u32x4*)(mix + (size_t)r * 2048 + 1024 + c0 + 8) = pack8(x + 8);
        }
    }
}

template <bool PARTS>
__device__ __forceinline__ void phase_final(const Params& p, const int rbeg, const int rend, const int blk0, const int nblk) {
    float* y = p.out + O_Y;
    const int tid = fresh_tid(), lane = tid & 63, wave = ((int)blockIdx.x - blk0) * 8 + (tid >> 6), nw = nblk * 8;
    for (int r = rbeg + wave; r < rend; r += nw) {
        f32x4 v[4]; float ss = 0.f;
#pragma unroll
        for (int i = 0; i < 4; ++i) {
            if (PARTS) { const size_t o = (size_t)(r - NROWS_P) * 1024 + lane * 4 + 256 * i; const float* pt = (const float*)(p.ws + WS_U0);
                v[i] = *(const f32x4*)(p.x_sample + o) + *(const f32x4*)(pt + o) + *(const f32x4*)(pt + 1048576 + o) + *(const f32x4*)(pt + 2 * 1048576 + o) + *(const f32x4*)(pt + 3 * 1048576 + o); }
            else v[i] = *(const f32x4*)(y + (size_t)r * 1024 + lane * 4 + 256 * i);
            ss += v[i][0] * v[i][0] + v[i][1] * v[i][1] + v[i][2] * v[i][2] + v[i][3] * v[i][3]; }
        ss = wave_sum(ss);
        const float rstd = rsqrtf(ss * (1.0f / 1024.0f) + 1e-6f);
#pragma unroll
        for (int i = 0; i < 4; ++i) { const f32x4 g = *(const f32x4*)(p.g_final + lane * 4 + 256 * i);
            *(f32x4*)(y + (size_t)r * 1024 + lane * 4 + 256 * i) = v[i] * rstd * g; }
    }
}

constexpr int QS = 272, K2S = 320, VS = 192, PS = 144;
constexpr int OFF_Q1 = 0, OFF_Q2 = 17408, OFF_KX = 34816, OFF_K2 = 52224, OFF_V = 72704, OFF_P = 84992, OFF_CT = 94208, OFF_VEC = 120320, OFF_B = 123392, OFF_TOT = 156160;
#define MFMA32(a, b, c) __builtin_amdgcn_mfma_f32_32x32x16_bf16((a), (b), (c), 0, 0, 0)
__device__ __forceinline__ int crow(int reg, int lane) { return (reg & 3) + 8 * (reg >> 2) + 4 * (lane >> 5); }
typedef short s16x4 __attribute__((ext_vector_type(4)));
__device__ __forceinline__ bf16x8 tr_frag(unsigned a0, unsigned a1) {
    s16x4 lo, hi;
    asm volatile("ds_read_b64_tr_b16 %0, %2\n\tds_read_b64_tr_b16 %1, %3\n\ts_waitcnt lgkmcnt(0)" : "=&v"(lo), "=&v"(hi) : "v"(a0), "v"(a1) : "memory");
    return (bf16x8){lo[0], lo[1], lo[2], lo[3], hi[0], hi[1], hi[2], hi[3]};
}

__device__ __forceinline__ void tr_frag4(const unsigned a0, const int S, bf16x8 (&f)[4]) {
    s16x4 r0, r1, r2, r3, r4, r5, r6, r7;
    const unsigned a1 = a0 + 4 * S, a2 = a0 + 16 * S, a3 = a0 + 20 * S, a4 = a0 + 32 * S, a5 = a0 + 36 * S, a6 = a0 + 48 * S, a7 = a0 + 52 * S;
    asm volatile("ds_read_b64_tr_b16 %0, %8\n\tds_read_b64_tr_b16 %1, %9\n\tds_read_b64_tr_b16 %2, %10\n\tds_read_b64_tr_b16 %3, %11\n\t"
                 "ds_read_b64_tr_b16 %4, %12\n\tds_read_b64_tr_b16 %5, %13\n\tds_read_b64_tr_b16 %6, %14\n\tds_read_b64_tr_b16 %7, %15\n\ts_waitcnt lgkmcnt(0)"
                 : "=&v"(r0), "=&v"(r1), "=&v"(r2), "=&v"(r3), "=&v"(r4), "=&v"(r5), "=&v"(r6), "=&v"(r7)
                 : "v"(a0), "v"(a1), "v"(a2), "v"(a3), "v"(a4), "v"(a5), "v"(a6), "v"(a7) : "memory");
    f[0] = (bf16x8){r0[0], r0[1], r0[2], r0[3], r1[0], r1[1], r1[2], r1[3]}; f[1] = (bf16x8){r2[0], r2[1], r2[2], r2[3], r3[0], r3[1], r3[2], r3[3]};
    f[2] = (bf16x8){r4[0], r4[1], r4[2], r4[3], r5[0], r5[1], r5[2], r5[3]}; f[3] = (bf16x8){r6[0], r6[1], r6[2], r6[3], r7[0], r7[1], r7[2], r7[3]};
}

template <int NT, bool IS_M>
__device__ __forceinline__ void scan_item(const Params& p, LAS unsigned char* lds, const int b, const int h, const int sl) {
    const int tid = fresh_tid(), wid = __builtin_amdgcn_readfirstlane(tid >> 6), lane = tid & 63, l31 = lane & 31, lh = lane >> 5;
    constexpr int nch = 32; const int row0 = b * 2048;
    LAS float* vec = (LAS float*)(lds + OFF_VEC);
    const unsigned ldsb = (unsigned)(size_t)lds;
    const bf16_t* gq; const bf16_t* gk; bf16_t* gv; int ldq; constexpr int ldv = 1024;
    if (IS_M) { gq = (const bf16_t*)((unsigned char*)p.out + YS_Q) + h * 128; gk = (const bf16_t*)((unsigned char*)p.out + YS_K) + h * 128; ldq = 512;
                gv = (bf16_t*)(p.ws + WS_U0) + h * 256 + sl * 64; }
    else { gq = (const bf16_t*)(p.ws + WS_U0 + 4 * UB) + h * 128; gk = (const bf16_t*)(p.ws + WS_U0 + 3 * UB) + h * 128; ldq = 1024;
           gv = (bf16_t*)(p.ws + WS_U0 + 5 * UB) + h * 128 + sl * 64; }
    const float* gates = (const float*)(p.ws + WS_GATES);
    const int kc = (tid & 15) * 8, tq = tid >> 4;
    const int dc = (tid & 7) * 8, tv = tid >> 3;
    const int trow = 8 * lh + ((lane & 15) >> 2), tcolb = (16 * ((lane >> 4) & 1) + 4 * (lane & 3)) * 2;
    if (!IS_M) { if (tid < 128) { const float p0 = p.lb_param[h * 128 + tid], p1 = p.lb_param[1024 + h * 128 + tid]; const float lb = __frcp_rn(1.0f + __expf(p1 - p0)); vec[384 + tid] = lb; vec[512 + tid] = 1.0f - lb; } }
    f32x16 st[NT];
#pragma unroll
    for (int j = 0; j < NT; ++j)
#pragma unroll
        for (int r = 0; r < 16; ++r) st[j][r] = 0.f;
    for (int i = tid; i < NT * 32 * QS / 16; i += 512) *(LAS u32x4*)(lds + OFF_CT + i * 16) = (u32x4){0u, 0u, 0u, 0u};
    if (IS_M) {
        if (tid < 64) { unsigned one = 0x3F80u; asm volatile("" : "+v"(one));
#pragma unroll
            for (int i = 0; i < 4; ++i) *(LAS u32x4*)(lds + OFF_V + tid * VS + 128 + 16 * i) = (u32x4){(i == 0) ? one : 0u, 0u, 0u, 0u}; }
    }
    LAS unsigned char* outb = lds + (IS_M ? OFF_B : OFF_CT + 64 * QS);
    LAS float* glds = (LAS float*)(lds + OFF_B + 8192); LAS float* dmt = (LAS float*)(lds + OFF_B + 8192 + 16384);
    if (IS_M) { for (int i = tid; i < 2048; i += 512) { const size_t gr = (size_t)(row0 + i) * 8; glds[2 * i] = gates[gr + h]; glds[2 * i + 1] = gates[gr + 4 + h]; } }
    __syncthreads();
    float m_run = 0.f;
    auto gate_vectors = [&](const int c) {
        LAS float* vb = vec + (c & 1) * 320;
        const float ig = glds[2 * (c * 64 + lane)], lf = glds[2 * (c * 64 + lane) + 1];
        float bc = lf;
#pragma unroll
        for (int o = 1; o < 64; o <<= 1) { const float u = __shfl_up(bc, o); if (lane >= o) bc += u; }
        const float a = ig - bc;
        float M = fmaxf(a, m_run);
#pragma unroll
        for (int o = 1; o < 64; o <<= 1) { const float u = __shfl_up(M, o); if (lane >= o) M = fmaxf(M, u); }
        const float M63 = __shfl(M, 63), b63 = __shfl(bc, 63);
        vb[lane] = a; vb[64 + lane] = M; vb[128 + lane] = __expf(M63 - M) * 0.08838834764831845f; vb[192 + lane] = __expf(a - M63);
        if (lane == 0) vb[256] = __expf(m_run - M63);
        vb[257 + lane] = bc + M;
        m_run = b63 + M63;
    };
    if (IS_M && wid == 7) gate_vectors(0);
    u32x4 rq[2], rk[2], rv;
#pragma unroll
    for (int i = 0; i < 2; ++i) { const unsigned ro = (unsigned)((row0 + tq + 32 * i) * ldq + kc); rq[i] = *(const u32x4*)(gq + ro); rk[i] = *(const u32x4*)(gk + ro); }
    rv = *(const u32x4*)(gv + (unsigned)((row0 + tv) * ldv + dc));
    __syncthreads();

#pragma unroll 1
    for (int c = 0; c < nch; ++c) {
        const int t0 = c * 64;
        LAS float* vb = vec + (c & 1) * 320;
        if (IS_M) {
#pragma unroll
            for (int i = 0; i < 2; ++i) { const int t = tq + 32 * i;
                *(LAS u32x4*)(lds + OFF_Q1 + t * QS + kc * 2) = rq[i];
                *(LAS u32x4*)(lds + OFF_KX + t * QS + kc * 2) = rk[i];
                *(LAS u32x4*)(lds + OFF_K2 + t * K2S + kc * 2) = rk[i]; }
            { float f[8]; unpack8(rv, f); const float ws_ = vb[192 + tv];
#pragma unroll
              for (int j = 0; j < 8; ++j) f[j] *= ws_;
              *(LAS u32x4*)(lds + OFF_V + tv * VS + dc * 2) = pack8(f); }
            if (tid < 64) *(LAS bf16_t*)(lds + OFF_V + tid * VS + 128) = f2bf(vb[192 + tid]);
        } else {
            LAS float* Bf = (LAS float*)(lds + OFF_B); LAS float* tot = (LAS float*)(lds + OFF_TOT);
#pragma unroll
            for (int i = 0; i < 2; ++i) { const int t = tq + 32 * i; float f[8]; unpack8(rk[i], f);
                *(LAS f32x4*)(Bf + t * 128 + kc) = (f32x4){f[0], f[1], f[2], f[3]}; *(LAS f32x4*)(Bf + t * 128 + kc + 4) = (f32x4){f[4], f[5], f[6], f[7]}; }
            __syncthreads();
            { const int k = tid & 127, seg = tid >> 7; float run = 0.f;
#pragma unroll
              for (int t = 0; t < 16; ++t) { run += Bf[(seg * 16 + t) * 128 + k]; Bf[(seg * 16 + t) * 128 + k] = run; }
              tot[seg * 128 + k] = run; }
            __syncthreads();
            float t0s[8], t1s[8], t2s[8], bmid[8], emid[8], elm[8];
#pragma unroll
            for (int j = 0; j < 8; ++j) { const int k = kc + j; t0s[j] = tot[k]; t1s[j] = tot[128 + k]; t2s[j] = tot[256 + k]; bmid[j] = Bf[31 * 128 + k] + t0s[j];
                const float blast = Bf[63 * 128 + k] + t0s[j] + t1s[j] + t2s[j]; emid[j] = __builtin_amdgcn_exp2f(bmid[j]); elm[j] = __builtin_amdgcn_exp2f(blast - bmid[j]); }
            const bool hiseg = (tq >= 16);
#pragma unroll
            for (int i = 0; i < 2; ++i) { const int t = tq + 32 * i; float fq[8], ff[8], q1[8], q2[8], kx[8], k2[8];
                unpack8(rq[i], fq); unpack8(rk[i], ff);
#pragma unroll
                for (int j = 0; j < 8; ++j) {
                    const float pre = (i == 0) ? (hiseg ? t0s[j] : 0.f) : (hiseg ? t0s[j] + t1s[j] + t2s[j] : t0s[j] + t1s[j]);
                    const float bb = Bf[t * 128 + kc + j] + pre;
                    const float qv = fq[j], kv = 1.0f - __builtin_amdgcn_exp2f(ff[j]);
                    const float e1 = __builtin_amdgcn_exp2f(bb - bmid[j]), r1 = __builtin_amdgcn_rcpf(e1);
                    q1[j] = qv * e1; q2[j] = q1[j] * emid[j]; kx[j] = kv * r1; k2[j] = kx[j] * elm[j];
                }
                *(LAS u32x4*)(lds + OFF_Q1 + t * QS + kc * 2) = pack8(q1);
                *(LAS u32x4*)(lds + OFF_Q2 + t * QS + kc * 2) = pack8(q2);
                *(LAS u32x4*)(lds + OFF_KX + t * QS + kc * 2) = pack8(kx);
                *(LAS u32x4*)(lds + OFF_K2 + t * K2S + kc * 2) = pack8(k2);
            }
            if (tq == 0) {
#pragma unroll
                for (int j = 0; j < 8; ++j) vec[kc + j] = emid[j] * elm[j]; }
        }
        if (!IS_M) *(LAS u32x4*)(lds + OFF_V + tv * VS + dc * 2) = rv;
        if (c > 0) {
            *(u32x4*)(gv + (unsigned)((row0 + t0 - 64 + tv) * ldv + dc)) = *(const LAS u32x4*)(outb + tv * 128 + dc * 2);
            if (IS_M && sl == 0 && tid < 64) { ((float*)(p.ws + WS_DEN))[(size_t)(row0 + t0 - 64 + tid) * 4 + h] = dmt[tid]; ((float*)(p.ws + WS_MT))[(size_t)(row0 + t0 - 64 + tid) * 4 + h] = vec[((c - 1) & 1) * 320 + 257 + tid]; }
        }
        if (c + 1 < nch) {
#pragma unroll
            for (int i = 0; i < 2; ++i) { const unsigned ro = (unsigned)((row0 + t0 + 64 + tq + 32 * i) * ldq + kc); rq[i] = *(const u32x4*)(gq + ro); rk[i] = *(const u32x4*)(gk + ro); }
            rv = *(const u32x4*)(gv + (unsigned)((row0 + t0 + 64 + tv) * ldv + dc));
        }
        __syncthreads();
        const int kb = lh * 16;
        constexpr int NU = (2 * NT + 3) / 4;
        f32x16 oacc[NU];
        if (wid < 4) {
            const int ti = wid >> 1, si = wid & 1;
            f32x16 sacc;
#pragma unroll
            for (int r = 0; r < 16; ++r) sacc[r] = 0.f;
            if (si <= ti) {
#pragma unroll
                for (int ks = 0; ks < 8; ++ks) { const bf16x8 a = *(const LAS bf16x8*)(lds + OFF_Q1 + (ti * 32 + l31) * QS + ks * 32 + kb), bb = *(const LAS bf16x8*)(lds + OFF_KX + (si * 32 + l31) * QS + ks * 32 + kb);
                    sacc = MFMA32(a, bb, sacc); }
            }
            const int s = si * 32 + l31;
            f32x4 rs4[4];
            if (IS_M) {
#pragma unroll
                for (int g = 0; g < 4; ++g) rs4[g] = *(const LAS f32x4*)(vb + 128 + ti * 32 + 8 * g + 4 * lh); }
#pragma unroll
            for (int r = 0; r < 16; ++r) { const int t = ti * 32 + crow(r, lane); float pv;
                if (IS_M) pv = (s <= t) ? sacc[r] * rs4[r >> 2][r & 3] : 0.f; else pv = (s <= t) ? sacc[r] : 0.f;
                *(LAS bf16_t*)(lds + OFF_P + t * PS + s * 2) = f2bf(pv); }
        } else {
#pragma unroll
            for (int u = 0; u < NU; ++u) { const int tile = (wid - 4) + 4 * u;
#pragma unroll
                for (int r = 0; r < 16; ++r) oacc[u][r] = 0.f;
                if (tile < 2 * NT) { const int ti = tile & 1, j = tile >> 1;
#pragma unroll
                    for (int ks = 0; ks < 8; ++ks) { const bf16x8 a = *(const LAS bf16x8*)(lds + (IS_M ? OFF_Q1 : OFF_Q2) + (ti * 32 + l31) * QS + ks * 32 + kb), bb = *(const LAS bf16x8*)(lds + OFF_CT + (j * 32 + l31) * QS + ks * 32 + kb);
                        oacc[u] = MFMA32(a, bb, oacc[u]); }
                    if (IS_M) { const float dcy = vb[256];
#pragma unroll
                        for (int g = 0; g < 4; ++g) { const f32x4 rs = *(const LAS f32x4*)(vb + 128 + ti * 32 + 8 * g + 4 * lh);
#pragma unroll
                            for (int e = 0; e < 4; ++e) oacc[u][4 * g + e] *= rs[e] * dcy; } } } }
        }
        __syncthreads();
        if (wid < 4) {
            float dec[IS_M ? 1 : 16];
            if (IS_M) dec[0] = vb[256];
            else {
#pragma unroll
                for (int r = 0; r < 16; ++r) dec[r] = vec[wid * 32 + crow(r, lane)]; }
            bf16x8 a[4];
            tr_frag4(ldsb + OFF_K2 + trow * K2S + wid * 64 + tcolb, K2S, a);
#pragma unroll
            for (int j = 0; j < NT; ++j) {
                bf16x8 bv[4];
                tr_frag4(ldsb + OFF_V + trow * VS + j * 64 + tcolb, VS, bv);
#pragma unroll
                for (int r = 0; r < 16; ++r) st[j][r] *= dec[IS_M ? 0 : r];
#pragma unroll
                for (int ks = 0; ks < 4; ++ks) st[j] = MFMA32(a[ks], bv[ks], st[j]);
#pragma unroll
                for (int g = 0; g < 4; ++g) { u32x2 w; w.x = cvt_pk_bf16(st[j][4 * g], st[j][4 * g + 1]); w.y = cvt_pk_bf16(st[j][4 * g + 2], st[j][4 * g + 3]);
                    *(LAS u32x2*)(lds + OFF_CT + (j * 32 + l31) * QS + (wid * 32 + 8 * g + 4 * lh) * 2) = w; }
            }
        } else {
#pragma unroll
            for (int u = 0; u < NU; ++u) { const int tile = (wid - 4) + 4 * u;
                if (tile < 2 * NT) { const int ti = tile & 1, j = tile >> 1;
                    bf16x8 pa[4], bv[4];
#pragma unroll
                    for (int ks = 0; ks < 4; ++ks) pa[ks] = *(const LAS bf16x8*)(lds + OFF_P + (ti * 32 + l31) * PS + ks * 32 + kb);
                    tr_frag4(ldsb + OFF_V + trow * VS + j * 64 + tcolb, VS, bv);
#pragma unroll
                    for (int ks = 0; ks < 4; ++ks) oacc[u] = MFMA32(pa[ks], bv[ks], oacc[u]);
                    if (j < 2) {
#pragma unroll
                        for (int r = 0; r < 16; ++r) { const int t = ti * 32 + crow(r, lane); *(LAS bf16_t*)(outb + t * 128 + (j * 32 + l31) * 2) = f2bf(oacc[u][r]); }
                    } else if (IS_M && l31 == 0) {
#pragma unroll
                        for (int r = 0; r < 16; ++r) { const int t = ti * 32 + crow(r, lane); dmt[t] = oacc[u][r]; }
                    } } }
            if (IS_M && wid == 7 && c + 1 < nch) gate_vectors(c + 1);
        }
        __syncthreads();
    }
    const int tid2 = fresh_tid(), lane2 = tid2 & 63, l31b = lane2 & 31, wid2 = __builtin_amdgcn_readfirstlane(tid2 >> 6);
    { const int tv2 = tid2 >> 3, dc2 = (tid2 & 7) * 8;
      *(u32x4*)(gv + (unsigned)((row0 + 2048 - 64 + tv2) * ldv + dc2)) = *(const LAS u32x4*)(outb + tv2 * 128 + dc2 * 2); }
    if (IS_M && sl == 0 && tid2 < 64) { ((float*)(p.ws + WS_DEN))[(size_t)(row0 + 2048 - 64 + tid2) * 4 + h] = dmt[tid2]; ((float*)(p.ws + WS_MT))[(size_t)(row0 + 2048 - 64 + tid2) * 4 + h] = vec[((nch - 1) & 1) * 320 + 257 + tid2]; }
    if (wid2 < 4) {
        float* Cout; float* nout = nullptr; int ldc;
        if (IS_M) { Cout = p.out + O_PC + ((size_t)b * 4 + h) * 128 * 256 + sl * 64; ldc = 256; nout = p.out + O_PN + ((size_t)b * 4 + h) * 128; }
        else { Cout = p.out + O_PS + ((size_t)b * 8 + h) * 128 * 128 + sl * 64; ldc = 128; }
#pragma unroll
        for (int j = 0; j < NT; ++j)
#pragma unroll
            for (int r = 0; r < 16; ++r) { const int dk = wid2 * 32 + crow(r, lane2);
                if (j < 2) Cout[(size_t)dk * ldc + j * 32 + l31b] = st[j][r];
                else if (IS_M && sl == 0 && l31b == 0) nout[dk] = st[j][r]; }
    }
    if (IS_M && sl == 0 && tid2 == 448) p.out[O_PM + b * 4 + h] = m_run;
    __syncthreads();
}

__device__ __forceinline__ f32x4 bf4_to_f32(const u32x2 w) { return (f32x4){bflo(w.x), bfhi(w.x), bflo(w.y), bfhi(w.y)}; }
__device__ __forceinline__ void sample_mlstm(const Params& p, LAS unsigned char* lds, const int b, const int h) {
    const int tid = fresh_tid(), dg = tid & 63, kq = tid >> 6;
    LAS float* qs = (LAS float*)lds; LAS float* ks = qs + 1024; LAS float* red = ks + 1024; LAS float* rden = red + 16384; LAS float* gsm = rden + 64;
    const int row0 = NROWS_P + b * 8;
    f32x4 C[16];
    { const float* C0 = p.st_C + (((size_t)b * 4 + h) * 128 + kq * 16) * 256 + dg * 4;
#pragma unroll
      for (int i = 0; i < 16; ++i) C[i] = *(const f32x4*)(C0 + i * 256); }
    float nn[16];
#pragma unroll
    for (int i = 0; i < 16; ++i) nn[i] = (dg == 0) ? p.st_n[((size_t)b * 4 + h) * 128 + kq * 16 + i] : 0.f;
    u32x2 vv[8];
    { bf16_t* v = (bf16_t*)(p.ws + WS_U0) + (size_t)row0 * 1024 + h * 256 + dg * 4;
#pragma unroll
      for (int t = 0; t < 8; ++t) vv[t] = *(const u32x2*)(v + t * 1024); }
    { const int t = tid >> 6, c = (tid & 63) * 2;
      const unsigned wq = *(const unsigned*)((const bf16_t*)((unsigned char*)p.out + YS_Q) + (size_t)(row0 + t) * 512 + h * 128 + c);
      const unsigned wk = *(const unsigned*)((const bf16_t*)((unsigned char*)p.out + YS_K) + (size_t)(row0 + t) * 512 + h * 128 + c);
      qs[t * 128 + c] = bflo(wq) * 0.08838834764831845f; qs[t * 128 + c + 1] = bfhi(wq) * 0.08838834764831845f; ks[t * 128 + c] = bflo(wk); ks[t * 128 + c + 1] = bfhi(wk); }
    if (tid == 0) { const float* g = (const float*)(p.ws + WS_GATES) + (size_t)row0 * 8; float m = p.st_m[b * 4 + h];
        for (int t = 0; t < 8; ++t) { const float ig = g[t * 8 + h], lf = g[t * 8 + 4 + h], mn = fmaxf(lf + m, ig);
            gsm[t] = __expf(lf + m - mn); gsm[8 + t] = __expf(ig - mn); gsm[16 + t] = mn; m = mn; } }
    __syncthreads();
#pragma unroll 1
    for (int t = 0; t < 8; ++t) {
        const float fg = gsm[t], ii = gsm[8 + t]; const f32x4 v4 = bf4_to_f32(vv[t]);
        f32x4 part = (f32x4){0.f, 0.f, 0.f, 0.f}; float pden = 0.f;
#pragma unroll
        for (int i = 0; i < 16; ++i) { const float kk = ks[t * 128 + kq * 16 + i] * ii, qv = qs[t * 128 + kq * 16 + i];
            C[i] = C[i] * fg + v4 * kk; part += C[i] * qv; nn[i] = nn[i] * fg + kk; pden += qv * nn[i]; }
        *(LAS f32x4*)(red + (kq * 8 + t) * 256 + dg * 4) = part;
        if (dg == 0) rden[kq * 8 + t] = pden;
    }
    __syncthreads();
    { const int t = tid >> 6; f32x4 sum = (f32x4){0.f, 0.f, 0.f, 0.f};
#pragma unroll
      for (int q = 0; q < 8; ++q) sum += *(const LAS f32x4*)(red + (q * 8 + t) * 256 + dg * 4);
      u32x2 w; w.x = cvt_pk_bf16(sum[0], sum[1]); w.y = cvt_pk_bf16(sum[2], sum[3]);
      *(u32x2*)((bf16_t*)(p.ws + WS_U0) + (size_t)(row0 + t) * 1024 + h * 256 + dg * 4) = w; }
    if (tid < 8) { float d = 0.f;
#pragma unroll
        for (int q = 0; q < 8; ++q) d += rden[q * 8 + tid];
        ((float*)(p.ws + WS_DEN))[(size_t)(row0 + tid) * 4 + h] = d; ((float*)(p.ws + WS_MT))[(size_t)(row0 + tid) * 4 + h] = gsm[16 + tid]; }
    { float* Co = p.out + O_SC + (((size_t)b * 4 + h) * 128 + kq * 16) * 256 + dg * 4;
#pragma unroll
      for (int i = 0; i < 16; ++i) *(f32x4*)(Co + i * 256) = C[i]; }
    if (dg == 0) {
#pragma unroll
        for (int i = 0; i < 16; ++i) p.out[O_SN + ((size_t)b * 4 + h) * 128 + kq * 16 + i] = nn[i]; }
    if (tid == 0) p.out[O_SM + b * 4 + h] = gsm[23];
    __syncthreads();
}
__device__ __forceinline__ void sample_hgrn(const Params& p, LAS unsigned char* lds, const int b, const int h) {
    const int tid = fresh_tid(), dg = tid & 31, kq = tid >> 5;
    LAS float* fs = (LAS float*)lds; LAS float* kks = fs + 1024; LAS float* qss = kks + 1024; LAS float* red = qss + 1024;
    const int row0 = NROWS_P + b * 8;
    f32x4 S[8];
    { const float* S0 = p.st_S + (((size_t)b * 8 + h) * 128 + kq * 8) * 128 + dg * 4;
#pragma unroll
      for (int i = 0; i < 8; ++i) S[i] = *(const f32x4*)(S0 + i * 128); }
    u32x2 vv[8];
    { const bf16_t* v = (const bf16_t*)(p.ws + WS_U0 + 5 * UB) + (size_t)row0 * 1024 + h * 128 + dg * 4;
#pragma unroll
      for (int t = 0; t < 8; ++t) vv[t] = *(const u32x2*)(v + t * 1024); }
    { const int t = tid >> 6, c = (tid & 63) * 2;
      const unsigned wf = *(const unsigned*)((const bf16_t*)(p.ws + WS_U0 + 3 * UB) + (size_t)(row0 + t) * 1024 + h * 128 + c);
      const unsigned wq = *(const unsigned*)((const bf16_t*)(p.ws + WS_U0 + 4 * UB) + (size_t)(row0 + t) * 1024 + h * 128 + c);
#pragma unroll
      for (int e = 0; e < 2; ++e) { const float fl = e ? bfhi(wf) : bflo(wf), qr = e ? bfhi(wq) : bflo(wq);
          const float p0 = p.lb_param[h * 128 + c + e], p1 = p.lb_param[1024 + h * 128 + c + e], lb = __frcp_rn(1.0f + __expf(p1 - p0)), sg = sigmoidf_(fl);
          fs[t * 128 + c + e] = lb + (1.0f - lb) * sg; kks[t * 128 + c + e] = (1.0f - lb) * (1.0f - sg); qss[t * 128 + c + e] = qr * sigmoidf_(qr); } }
    __syncthreads();
#pragma unroll 1
    for (int t = 0; t < 8; ++t) {
        const f32x4 v4 = bf4_to_f32(vv[t]); f32x4 part = (f32x4){0.f, 0.f, 0.f, 0.f};
#pragma unroll
        for (int i = 0; i < 8; ++i) { const int dk = t * 128 + kq * 8 + i; S[i] = S[i] * fs[dk] + v4 * kks[dk]; part += S[i] * qss[dk]; }
        *(LAS f32x4*)(red + (kq * 8 + t) * 128 + dg * 4) = part;
    }
    __syncthreads();
    if (tid < 256) { const int t = tid >> 5; f32x4 sum = (f32x4){0.f, 0.f, 0.f, 0.f};
#pragma unroll
      for (int q = 0; q < 16; ++q) sum += *(const LAS f32x4*)(red + (q * 8 + t) * 128 + dg * 4);
      u32x2 w; w.x = cvt_pk_bf16(sum[0], sum[1]); w.y = cvt_pk_bf16(sum[2], sum[3]);
      *(u32x2*)((bf16_t*)(p.ws + WS_U0 + 5 * UB) + (size_t)(row0 + t) * 1024 + h * 128 + dg * 4) = w; }
    { float* So = p.out + O_SS + (((size_t)b * 8 + h) * 128 + kq * 8) * 128 + dg * 4;
#pragma unroll
      for (int i = 0; i < 8; ++i) *(f32x4*)(So + i * 128) = S[i]; }
    __syncthreads();
}

__device__ __forceinline__ void phase_scan(const Params& p, LAS unsigned char* lds) {
    for (int it = blockIdx.x; it < 256; it += gridDim.x) {
        if (it < 128) scan_item<3, true>(p, lds, it >> 4, (it >> 2) & 3, it & 3);
        else { const int i = it - 128; scan_item<2, false>(p, lds, i >> 4, (i >> 1) & 7, i & 1); }
    }
    for (int it = blockIdx.x; it < 1536; it += gridDim.x) {
        if (it < 512) sample_mlstm(p, lds, it >> 2, it & 3);
        else { const int i = it - 512; sample_hgrn(p, lds, i >> 3, i & 7); }
    }
}

template <int PH> __device__ __forceinline__ void run_phase(const Params& p, LAS unsigned char* lds) {
    if constexpr (PH == 0) phase_prep(p, lds);
    if constexpr (PH == 1) {
        pg8::TileOrder S; S.init(NROWS, 7168, 1024, 1024, gridDim.x, blockIdx.x, (unsigned char*)p.out + YS_XN, (unsigned char*)p.out + YS_WIN);
        pg8::EpiProj E{p.ws, p.lb_param};
        pg8::gemm_phase(lds, 1024, 1024, S, E);
    }
    if constexpr (PH == 2) phase_conv(p);
    if constexpr (PH == 3) {
        { pg8::QkvOrder<0> S{(int)gridDim.x, (int)blockIdx.x, (const char*)p.out + YS_XC, (const char*)p.ws + WS_WQK};
          pg8::EpiQkv<0> E{(bf16_t*)((unsigned char*)p.out + YS_Q)};
          pg8::gemm_phase(lds, 256, 1024, S, E); }
        { pg8::QkvOrder<1> S{(int)gridDim.x, (int)blockIdx.x, (const char*)p.ws + WS_U0, (const char*)p.ws + WS_WV};
          pg8::EpiQkv<1> E{(bf16_t*)(p.ws + WS_U0)};
          pg8::gemm_phase(lds, 256, 1024, S, E); }
    }
    if constexpr (PH == 4) phase_gates(p, lds);
    if constexpr (PH == 5) phase_scan(p, lds);
    if constexpr (PH == 6) phase_post(p);
    if constexpr (PH == 7) {
        pg8::TileOrder S; S.init(NROWS_P, 1024, 2048, 2048, gridDim.x, blockIdx.x, p.ws + WS_U0 + 3 * UB, p.ws + WS_WOUT);
        pg8::EpiOut E{p.out + O_Y, p.x_prompt};
        pg8::gemm_phase(lds, 2048, 2048, S, E);
    }
    if constexpr (PH == 8) {
        if (blockIdx.x < 64) {
            pg8::TailOrder S{(int)blockIdx.x, (const char*)p.ws + WS_U0 + 3 * UB + (size_t)NROWS_P * 2048 * 2, (const char*)p.ws + WS_WOUT};
            pg8::EpiPart E{(float*)(p.ws + WS_U0)};
            pg8::gemm_phase(lds, 512, 2048, S, E, 2048);
        } else phase_final<false>(p, 0, NROWS_P, 64, (int)gridDim.x - 64);
    }
    if constexpr (PH == 9) phase_final<true>(p, NROWS_P, NROWS, 0, (int)gridDim.x);
}

#define XB_XCNT(j)  (64 * (j))
#define XB_XSUB(j)  (1024 + 64 * (j))
#define XB_XGEN(j)  (2048 + 64 * (j))
#define XB_TOP      3072
#define XB_TOPGEN   3136
#define XB_WORDS    3200
__device__ __forceinline__ unsigned xb_ld(unsigned* p) { return __hip_atomic_load(p, __ATOMIC_RELAXED, __HIP_MEMORY_SCOPE_AGENT); }
__device__ __forceinline__ unsigned xb_add(unsigned* p, unsigned v) { return __hip_atomic_fetch_add(p, v, __ATOMIC_RELAXED, __HIP_MEMORY_SCOPE_AGENT); }
__device__ __forceinline__ unsigned xb_xcc_id() { return (unsigned)__builtin_amdgcn_s_getreg((3 << 11) | 20) & 0xFu; }
#define XB_SPIN(cond) do { unsigned _sp = 0; while (cond) { __builtin_amdgcn_s_sleep(1); if (++_sp > (1u << 22)) break; } } while (0)
__device__ __forceinline__ void grid_barrier(unsigned* bar, volatile LAS unsigned* st) {
    asm volatile("s_waitcnt vmcnt(0)" ::: "memory");
    __syncthreads();
    if (threadIdx.x == 0) {
        __builtin_amdgcn_s_waitcnt(0);
        const unsigned x = st[0]; unsigned nloc = st[1], nx = st[2];
        if (nloc == 0u) {
            const unsigned G = gridDim.x; unsigned sum, cnt, mine, sp = 0u;
            for (;;) { sum = 0u; cnt = 0u; mine = 0u;
                for (unsigned j = 0; j < 16; ++j) { const unsigned c = xb_ld(&bar[XB_XCNT(j)]); sum += c; cnt += (c > 0u) ? 1u : 0u; mine = (j == x) ? c : mine; }
                if (sum == G || ++sp > (1u << 22)) break;
                __builtin_amdgcn_s_sleep(1); }
            nloc = mine > 0u ? mine : 1u; nx = cnt > 0u ? cnt : 1u; st[1] = nloc; st[2] = nx; }
        const unsigned old = xb_add(&bar[XB_XSUB(x)], 1u), gen = old / nloc;
        if (old + 1u == (gen + 1u) * nloc) {
            __builtin_amdgcn_fence(__ATOMIC_RELEASE, "agent");
            asm volatile("s_waitcnt vmcnt(0)" ::: "memory");
            const unsigned og = xb_add(&bar[XB_TOP], 1u), tg = og / nx;
            if (og + 1u == (tg + 1u) * nx) xb_add(&bar[XB_TOPGEN], 1u);
            else XB_SPIN(xb_ld(&bar[XB_TOPGEN]) == tg);
            __builtin_amdgcn_fence(__ATOMIC_ACQUIRE, "agent");
            xb_add(&bar[XB_XGEN(x)], 1u);
            asm volatile("s_waitcnt vmcnt(0)" ::: "memory");
        } else {
            XB_SPIN(xb_ld(&bar[XB_XGEN(x)]) == gen);
            __builtin_amdgcn_fence(__ATOMIC_ACQUIRE, "agent");
            asm volatile("s_waitcnt vmcnt(0)" ::: "memory");
        }
    }
    __syncthreads();
}
#ifndef MK_ONE
#define MK_ONE 1
#endif
#if MK_ONE
__global__ void __launch_bounds__(512, 2) fwd_megakernel(Params p) {
    extern __shared__ __attribute__((aligned(16))) unsigned char smem[];
    LAS unsigned char* lds = (LAS unsigned char*)smem;
    cg::grid_group grid = cg::this_grid();
    unsigned* bar = (unsigned*)(p.ws + WS_END);
    volatile LAS unsigned* st = (volatile LAS unsigned*)(lds + LDS_BYTES - 16);
    if (threadIdx.x == 0) { const unsigned x = xb_xcc_id(); st[0] = x; st[1] = 0u; (void)xb_add(&bar[XB_XCNT(x)], 1u); }
    run_phase<0>(p, lds); grid_barrier(bar, st);
    run_phase<1>(p, lds); grid.sync();
    run_phase<2>(p, lds); grid_barrier(bar, st);
    run_phase<3>(p, lds); grid_barrier(bar, st);
    run_phase<4>(p, lds); grid_barrier(bar, st);
    run_phase<5>(p, lds); grid_barrier(bar, st);
    run_phase<6>(p, lds); grid_barrier(bar, st);
    run_phase<7>(p, lds); grid_barrier(bar, st);
    run_phase<8>(p, lds); grid_barrier(bar, st);
    run_phase<9>(p, lds);
}
#else
template <int PH> __global__ void __launch_bounds__(512, 2) phase_kernel(Params p) {
    extern __shared__ __attribute__((aligned(16))) unsigned char smem[];
    run_phase<PH>(p, (LAS unsigned char*)smem);
}
template <int PH> static void launch_phase(const Params& p, int grid, hipStream_t stream) {
    static bool attr = false;
    if (!attr) { (void)hipFuncSetAttribute((const void*)phase_kernel<PH>, hipFuncAttributeMaxDynamicSharedMemorySize, LDS_BYTES); attr = true; }
    hipLaunchKernelGGL(phase_kernel<PH>, dim3(grid), dim3(512), LDS_BYTES, stream, p);
}
#endif

extern "C" void kernel_launch(void* const* d_in, const int* in_sizes, int n_in, void* d_out, int out_size, void* d_ws, size_t ws_size, hipStream_t stream) {
    static int grid_blocks = 0;
    if (grid_blocks == 0) {
        if (n_in != 22 || ws_size < WS_END + 12800) { fprintf(stderr, "kernel_launch: unexpected n_in %d / ws_size %zu\n", n_in, ws_size); grid_blocks = -1; return; }
        int dev = 0, cus = 0;
        (void)hipGetDevice(&dev);
        (void)hipDeviceGetAttribute(&cus, hipDeviceAttributeMultiprocessorCount, dev);
#if MK_ONE
        int per_cu = 0;
        if (hipFuncSetAttribute((const void*)fwd_megakernel, hipFuncAttributeMaxDynamicSharedMemorySize, LDS_BYTES) != hipSuccess) { fprintf(stderr, "kernel_launch: hipFuncSetAttribute failed\n"); grid_blocks = -1; return; }
        (void)hipOccupancyMaxActiveBlocksPerMultiprocessor(&per_cu, (const void*)fwd_megakernel, 512, LDS_BYTES);
        if (per_cu < 1) per_cu = 1;
        grid_blocks = cus * per_cu;
#else
        grid_blocks = cus;
#endif
    }
    if (grid_blocks < 0) return;
    Params p{};
    const float** f = (const float**)&p;
    for (int i = 0; i < 22; ++i) f[i] = (const float*)d_in[i];
    p.out = (float*)d_out; p.ws = (unsigned char*)d_ws;
#if MK_ONE
    (void)hipMemsetAsync((unsigned char*)d_ws + WS_END, 0, 12800, stream);
    void* args[] = {&p};
    hipError_t e = hipLaunchCooperativeKernel((const void*)fwd_megakernel, dim3(grid_blocks), dim3(512), args, LDS_BYTES, stream);
    if (e != hipSuccess) fprintf(stderr, "cooperative launch failed: %s (grid %d)\n", hipGetErrorString(e), grid_blocks);
#else
    launch_phase<0>(p, grid_blocks, stream); launch_phase<1>(p, grid_blocks, stream); launch_phase<2>(p, grid_blocks, stream);
    launch_phase<3>(p, grid_blocks, stream); launch_phase<4>(p, grid_blocks, stream); launch_phase<5>(p, grid_blocks, stream);
    launch_phase<6>(p, grid_blocks, stream); launch_phase<7>(p, grid_blocks, stream); launch_phase<8>(p, grid_blocks, stream); launch_phase<9>(p, grid_blocks, stream);
#endif
}
```
